# Optimizing an MI355X kernel written in HIP

```python
import jax, jax.numpy as jnp
from jax import lax
import numpy as np

D_MODEL = 4096
BATCH = 4
SEQ = 4096
DEPTH = 2
DEC_BATCH = 2
DEC_SEQ = 4096
PAST_LEN = 128

GRID_W = 64
PLE_DIM = 256
NA_HEADS = 16
NA_HEAD_DIM = 128
NA_WIDTH = NA_HEADS * NA_HEAD_DIM
NA_WIN_ROWS = 8
NA_WIN_COLS = 16
RET_HEADS = 8
RET_QK_DIM = 128
RET_V_DIM = 256
RET_QK_WIDTH = RET_HEADS * RET_QK_DIM
RET_V_WIDTH = RET_HEADS * RET_V_DIM
RET_CHUNK = 128
ROPE_BASE = 10000.0
EPS = 1e-6
SPLITS = (NA_WIDTH, NA_WIDTH, NA_WIDTH, NA_WIDTH,
          RET_QK_WIDTH, RET_QK_WIDTH, RET_V_WIDTH, RET_V_WIDTH,
          D_MODEL, D_MODEL)
IN_WIDTH = sum(SPLITS)

kernel_name = 'hybrid_natten_retention_encoder'


def rmsnorm(x, g):
    xf = x.astype(jnp.float32)
    y = xf * lax.rsqrt(jnp.mean(xf * xf, axis=-1, keepdims=True) + EPS)
    return (y * g.astype(jnp.float32)).astype(x.dtype)


def rotary(t, positions):
    half = t.shape[-1] // 2
    inv = ROPE_BASE ** (-jnp.arange(half, dtype=jnp.float32) / half)
    ang = positions.astype(jnp.float32)[:, None] * inv[None, :]
    cos = jnp.cos(ang)[None, :, None, :]
    sin = jnp.sin(ang)[None, :, None, :]
    t1 = t[..., :half].astype(jnp.float32)
    t2 = t[..., half:].astype(jnp.float32)
    return jnp.concatenate([t1 * cos - t2 * sin, t1 * sin + t2 * cos], axis=-1).astype(t.dtype)


def neighborhood_attention(q, k, v, rpb):
    B, S, _ = q.shape
    rows = S // GRID_W
    wr = min(NA_WIN_ROWS, rows)
    grid = lambda t: t.reshape(B, rows, GRID_W, NA_HEADS, NA_HEAD_DIM)
    qg, kg, vg = grid(q), grid(k), grid(v)
    cols = jnp.arange(GRID_W)
    col_start = jnp.clip(cols - NA_WIN_COLS // 2, 0, GRID_W - NA_WIN_COLS)
    col_valid = (cols[None, :] >= col_start[:, None]) & (cols[None, :] < col_start[:, None] + NA_WIN_COLS)
    col_idx = jnp.clip(cols[None, :] - cols[:, None] + NA_WIN_COLS - 1, 0, 2 * NA_WIN_COLS - 2)
    scale = NA_HEAD_DIM ** -0.5

    def one_row(r):
        rs = jnp.clip(r - wr // 2, 0, rows - wr)
        q_r = lax.dynamic_index_in_dim(qg, r, axis=1, keepdims=False)
        k_r = lax.dynamic_slice_in_dim(kg, rs, wr, axis=1)
        v_r = lax.dynamic_slice_in_dim(vg, rs, wr, axis=1)
        s = jnp.einsum('bqhd,bwkhd->bhqwk', q_r, k_r, preferred_element_type=jnp.float32) * scale
        row_idx = rs + jnp.arange(wr) - r + NA_WIN_ROWS - 1
        bias = rpb[:, row_idx][:, :, col_idx].transpose(0, 2, 1, 3)
        s = s + bias.astype(jnp.float32)[None]
        s = jnp.where(col_valid[None, None, :, None, :], s, -jnp.inf)
        p = jax.nn.softmax(s, axis=(-2, -1))
        return jnp.einsum('bhqwk,bwkhd->bqhd', p.astype(v_r.dtype), v_r)

    out = lax.map(one_row, jnp.arange(rows))
    return out.transpose(1, 0, 2, 3, 4).reshape(B, S, NA_WIDTH)


def chunkwise_retention(q, k, v, log_decay):
    B, H, N, C, dk = q.shape
    dv = v.shape[-1]
    pos = jnp.arange(C, dtype=jnp.float32)
    ld = log_decay[:, None]
    diff = pos[:, None] - pos[None, :]
    decay_mat = jnp.where(diff[None] >= 0, jnp.exp(ld[:, :, None] * jnp.maximum(diff, 0.0)[None]), 0.0)
    scores = jnp.einsum('bhncd,bhnsd->bhncs', q, k) * decay_mat[None, :, None]
    inner = jnp.einsum('bhncs,bhnse->bhnce', scores, v)
    q_decay = jnp.exp(ld * (pos[None, :] + 1.0))
    k_decay = jnp.exp(ld * (C - 1.0 - pos[None, :]))
    chunk_decay = jnp.exp(log_decay * C)
    kv = jnp.einsum('bhncd,hc,bhnce->bhnde', k, k_decay, v)

    def step(state, kv_n):
        return state * chunk_decay[None, :, None, None] + kv_n, state

    init = jnp.zeros((B, H, dk, dv), jnp.float32)
    _, prev = lax.scan(step, init, jnp.moveaxis(kv, 2, 0))
    prev = jnp.moveaxis(prev, 0, 2)
    cross = jnp.einsum('bhncd,bhnde->bhnce', q * q_decay[None, :, None, :, None], prev)
    return inner + cross


def retention_branch(q, k, v, log_decay_fwd, log_decay_bwd, gn_gain):
    B, S, _ = q.shape
    n_chunks = S // RET_CHUNK
    pos = jnp.arange(S)
    q = rotary(q.reshape(B, S, RET_HEADS, RET_QK_DIM), pos)
    k = rotary(k.reshape(B, S, RET_HEADS, RET_QK_DIM), pos) * (RET_QK_DIM ** -0.5)
    v4 = v.reshape(B, S, RET_HEADS, RET_V_DIM)
    chunk = lambda t: t.astype(jnp.float32).reshape(B, n_chunks, RET_CHUNK, RET_HEADS, -1).transpose(0, 3, 1, 2, 4)
    unchunk = lambda t: t.transpose(0, 2, 3, 1, 4).reshape(B, S, RET_HEADS, RET_V_DIM)
    flip = lambda t: jnp.flip(t, axis=1)
    ld_f = -jnp.abs(log_decay_fwd.astype(jnp.float32))
    ld_b = -jnp.abs(log_decay_bwd.astype(jnp.float32))
    fwd = unchunk(chunkwise_retention(chunk(q), chunk(k), chunk(v4), ld_f))
    bwd = flip(unchunk(chunkwise_retention(chunk(flip(q)), chunk(flip(k)), chunk(flip(v4)), ld_b)))
    o = fwd + bwd
    o = o * lax.rsqrt(jnp.mean(o * o, axis=-1, keepdims=True) + EPS)
    o = o * gn_gain.astype(jnp.float32).reshape(RET_HEADS, RET_V_DIM)
    return o.reshape(B, S, RET_V_WIDTH).astype(v.dtype)


def encoder_layer(x, p_i, w_in, ln_pre, ln_post, na_rpb, ret_ld_f, ret_ld_b, ret_gn,
                  w_proj_a, w_proj_b, w_out, w_ple, w_ple_gate):
    xn = rmsnorm(x, ln_pre)
    proj = xn @ w_in
    offsets = [int(o) for o in np.cumsum(SPLITS)[:-1]]
    na_q, na_k, na_v, na_g, r_q, r_k, r_v, r_g, gate_a, gate_b = jnp.split(proj, offsets, axis=-1)
    a = neighborhood_attention(na_q, na_k, na_v, na_rpb) * jax.nn.silu(na_g)
    b = retention_branch(r_q, r_k, r_v, ret_ld_f, ret_ld_b, ret_gn) * jax.nn.silu(r_g)
    merged = jax.nn.sigmoid(gate_a) * (a @ w_proj_a) + jax.nn.sigmoid(gate_b) * (b @ w_proj_b)
    x = x + rmsnorm(merged @ w_out, ln_post)
    x = x + jax.nn.sigmoid(x @ w_ple_gate) * (p_i @ w_ple)
    return x


def trunk(x, p, w_in, ln_pre, ln_post, na_rpb, ret_log_decay_fwd, ret_log_decay_bwd, ret_gn_gain,
          w_proj_a, w_proj_b, w_out, w_ple, w_ple_gate):
    for i in range(DEPTH):
        x = encoder_layer(x, p[i], w_in[i], ln_pre[i], ln_post[i], na_rpb[i],
                          ret_log_decay_fwd[i], ret_log_decay_bwd[i], ret_gn_gain[i],
                          w_proj_a[i], w_proj_b[i], w_out[i], w_ple[i], w_ple_gate[i])
    return x


def setup_inputs(seed: int = 0) -> dict:
    key = jax.random.key(seed)
    ks = jax.random.split(key, 17)
    f32 = jnp.float32
    nrm = lambda k, shape, s: jax.random.normal(k, shape, f32) * s
    base_ld = jnp.asarray(np.log(1.0 - 2.0 ** (-5.0 - np.arange(RET_HEADS))), f32)
    return {
        'x_prompt': nrm(ks[0], (BATCH, SEQ, D_MODEL), 1.0),
        'x_sample': nrm(ks[1], (DEC_BATCH, DEC_SEQ, D_MODEL), 1.0),
        'p_prompt': nrm(ks[2], (DEPTH, BATCH, SEQ, PLE_DIM), 1.0),
        'p_sample': nrm(ks[3], (DEPTH, DEC_BATCH, DEC_SEQ, PLE_DIM), 1.0),
        'w_in': nrm(ks[4], (DEPTH, D_MODEL, IN_WIDTH), D_MODEL ** -0.5),
        'ln_pre': 1.0 + nrm(ks[5], (DEPTH, D_MODEL), 0.02),
        'ln_post': 1.0 + nrm(ks[6], (DEPTH, D_MODEL), 0.02),
        'na_rpb': nrm(ks[7], (DEPTH, NA_HEADS, 2 * NA_WIN_ROWS - 1, 2 * NA_WIN_COLS - 1), 0.1),
        'ret_log_decay_fwd': base_ld[None] * (1.0 + nrm(ks[8], (DEPTH, RET_HEADS), 0.05)),
        'ret_log_decay_bwd': base_ld[None] * (1.0 + nrm(ks[9], (DEPTH, RET_HEADS), 0.05)),
        'ret_gn_gain': 1.0 + nrm(ks[10], (DEPTH, RET_V_WIDTH), 0.02),
        'w_proj_a': nrm(ks[11], (DEPTH, NA_WIDTH, D_MODEL), NA_WIDTH ** -0.5),
        'w_proj_b': nrm(ks[12], (DEPTH, RET_V_WIDTH, D_MODEL), RET_V_WIDTH ** -0.5),
        'w_out': nrm(ks[13], (DEPTH, D_MODEL, D_MODEL), D_MODEL ** -0.5),
        'w_ple': nrm(ks[14], (DEPTH, PLE_DIM, D_MODEL), PLE_DIM ** -0.5),
        'w_ple_gate': nrm(ks[15], (DEPTH, D_MODEL, D_MODEL), D_MODEL ** -0.5),
    }


def reference(x_prompt, x_sample, p_prompt, p_sample, w_in, ln_pre, ln_post, na_rpb,
              ret_log_decay_fwd, ret_log_decay_bwd, ret_gn_gain, w_proj_a, w_proj_b,
              w_out, w_ple, w_ple_gate):
    y_prompt = trunk(x_prompt, p_prompt, w_in, ln_pre, ln_post, na_rpb, ret_log_decay_fwd,
                     ret_log_decay_bwd, ret_gn_gain, w_proj_a, w_proj_b, w_out, w_ple, w_ple_gate)
    y_sample = trunk(x_sample, p_sample, w_in, ln_pre, ln_post, na_rpb, ret_log_decay_fwd,
                     ret_log_decay_bwd, ret_gn_gain, w_proj_a, w_proj_b, w_out, w_ple, w_ple_gate)
    return (y_prompt, y_sample)
```

```cpp
#include <hip/hip_runtime.h>
#include <cstdio>
#include <cstdint>

#ifndef MK_MULTI
#define MK_MULTI 1
#endif
#ifndef PH_MASK
#define PH_MASK 0xFFFFF
#endif
#define PH_ON(b) ((PH_MASK >> (b)) & 1)

#define GAS __attribute__((address_space(1)))
#define LAS __attribute__((address_space(3)))
typedef unsigned short bf16;
typedef unsigned v4u __attribute__((ext_vector_type(4)));
typedef unsigned v2u __attribute__((ext_vector_type(2)));
typedef float f32x4 __attribute__((ext_vector_type(4)));
typedef float f32x2 __attribute__((ext_vector_type(2)));
typedef short bf16x8 __attribute__((ext_vector_type(8)));
typedef short s16x4 __attribute__((ext_vector_type(4)));

constexpr int DM = 4096, NTOK = 24576, NTOK_P = 16384, SEQ = 4096, NSEQ = 6, DEPTH = 2;
constexpr int INW = 22528, PLE = 256;
constexpr int LD_NA = 8192, LD_RT = 6144, LD_GT = 8192;
constexpr float EPS = 1e-6f;

constexpr size_t MiB = 1u << 20;
constexpr size_t WS_CTL = 0, CTL_ZERO_BYTES = 64 * 1024;
constexpr size_t WS_COS = 1 * MiB, WS_SIN = 2 * MiB, WS_RSTD = 3 * MiB, WS_PART = 4 * MiB, WS_PART2 = 10 * MiB;
constexpr size_t WS_WIN = 16 * MiB;
constexpr size_t WS_WPA = 368 * MiB, WS_WPB = 400 * MiB;
constexpr size_t WS_WOUT = 432 * MiB, WS_WG = 496 * MiB;
constexpr size_t WS_WPLE = 560 * MiB;
constexpr size_t WS_PB = 564 * MiB;
constexpr size_t WS_XBA = 588 * MiB, WS_XBB = 780 * MiB;
constexpr size_t WS_PNA = 972 * MiB;
constexpr size_t WS_PRT = 1356 * MiB;
constexpr size_t WS_PGT = 1644 * MiB;
constexpr size_t WS_AO = 2028 * MiB, WS_BO = 2124 * MiB;
constexpr size_t WS_MRG = 2220 * MiB, WS_Y = 2412 * MiB;
constexpr size_t WS_KVS = 2604 * MiB;
constexpr size_t WS_T = WS_PNA;
constexpr size_t WS_E = WS_PRT;
constexpr size_t WS_END = 2796 * MiB;
constexpr int CW_TMO = 0, CW_BAR = 1024;
constexpr size_t WS_PRM = 3 * MiB + 512 * 1024;
constexpr int PRM_RPB = 0, PRM_LDF = 14880, PRM_LDB = 14896, PRM_GN = 14912, PRM_LNPOST = 19008, PRM_N = 27200;

constexpr int LDS_BYTES = 155648;
constexpr int MISC_OFF = 153600;

__device__ __forceinline__ unsigned f2bf(float f) { unsigned u = __builtin_bit_cast(unsigned, f); return (u + 0x7fffu + ((u >> 16) & 1u)) >> 16; }
__device__ __forceinline__ unsigned pk2(float lo, float hi) { unsigned r; asm volatile("v_cvt_pk_bf16_f32 %0, %1, %2" : "=v"(r) : "v"(lo), "v"(hi)); return r; }
__device__ __forceinline__ float bflo(unsigned u) { return __builtin_bit_cast(float, u << 16); }
__device__ __forceinline__ float bfhi(unsigned u) { return __builtin_bit_cast(float, u & 0xffff0000u); }
__device__ __forceinline__ float sigmoidf_(float x) { return __builtin_amdgcn_rcpf(1.0f + __builtin_amdgcn_exp2f(-1.4426950408889634f * x)); }
__device__ __forceinline__ float expf_(float x) { return __builtin_amdgcn_exp2f(1.4426950408889634f * x); }
__device__ __forceinline__ float wave_sum(float v) {
#pragma unroll
    for (int o = 1; o < 64; o <<= 1) v += __shfl_xor(v, o);
    return v;
}
#define LDS_WAIT() asm volatile("s_waitcnt lgkmcnt(0)" ::: "memory")
#define VM_WAIT() asm volatile("s_waitcnt vmcnt(0)" ::: "memory")
__device__ __forceinline__ bf16x8 tr2(unsigned a0, unsigned a1) {
    s16x4 lo, hi;
    asm volatile("ds_read_b64_tr_b16 %0, %2\n\tds_read_b64_tr_b16 %1, %3\n\ts_waitcnt lgkmcnt(0)" : "=&v"(lo), "=&v"(hi) : "v"(a0), "v"(a1) : "memory");
    bf16x8 r; r[0] = lo[0]; r[1] = lo[1]; r[2] = lo[2]; r[3] = lo[3]; r[4] = hi[0]; r[5] = hi[1]; r[6] = hi[2]; r[7] = hi[3]; return r;
}
__device__ __forceinline__ void tr2x2(bf16x8& r0, bf16x8& r1, unsigned a0, unsigned a1, unsigned b0, unsigned b1) {
    s16x4 l0, h0, l1, h1;
    asm volatile("ds_read_b64_tr_b16 %0, %4\n\tds_read_b64_tr_b16 %1, %5\n\tds_read_b64_tr_b16 %2, %6\n\tds_read_b64_tr_b16 %3, %7\n\ts_waitcnt lgkmcnt(0)"
                 : "=&v"(l0), "=&v"(h0), "=&v"(l1), "=&v"(h1) : "v"(a0), "v"(a1), "v"(b0), "v"(b1) : "memory");
    r0[0] = l0[0]; r0[1] = l0[1]; r0[2] = l0[2]; r0[3] = l0[3]; r0[4] = h0[0]; r0[5] = h0[1]; r0[6] = h0[2]; r0[7] = h0[3];
    r1[0] = l1[0]; r1[1] = l1[1]; r1[2] = l1[2]; r1[3] = l1[3]; r1[4] = h1[0]; r1[5] = h1[1]; r1[6] = h1[2]; r1[7] = h1[3];
}
#define MFMA16(a, b, c) __builtin_amdgcn_mfma_f32_16x16x32_bf16((a), (b), (c), 0, 0, 0)

namespace pg8 {
#define PG8_LAS __attribute__((address_space(3)))
constexpr int BM = 256, BK = 64, HALF = 128, HTB = HALF * BK * 2, STAGE_BYTES = 8 * HTB, NXCD = 8, WGM = 8;
__host__ __device__ __forceinline__ int lds_byte(int r, int c) { const int st = (r >> 4) * 2 + (c >> 5), rr = r & 15, cc = c & 31, ob = rr * 64 + cc * 2; return st * 1024 + (ob ^ (((ob >> 9) & 1) << 5)); }
__host__ __device__ __forceinline__ void stage_rc(int b, int& R, int& C) { const int st = b / 1024, sb = b % 1024, swz = sb ^ (((sb >> 9) & 1) << 5); R = (st >> 1) * 16 + swz / 64; C = (st & 1) * 32 + (swz % 64) / 2; }
__host__ __device__ __forceinline__ int perm32(int rho) { const int n = rho >> 4, i = rho & 15; return 8 * (i >> 2) + 4 * n + (i & 3); }
struct Unit { int pm, pn, pass; };
template <int NP> struct Order {
    int nM, nN, nwg, G, c; const char* A[NP]; const char* B[NP]; size_t tstep;
    __device__ __forceinline__ void init(int M, int N, int K, int G_, int c_) { nM = M / BM; nN = N / BM; nwg = nM * nN; G = G_; c = c_; tstep = (size_t)BM * K * 2; }
    __device__ __forceinline__ bool next(int i, Unit& u) const {
        const int tile = i / NP; u.pass = i - tile * NP;
        const long L = (long)tile * G + c; if (L >= nwg) return false;
        int wgid = (int)L; { const int q = nwg / NXCD, r = nwg % NXCD, xcd = wgid % NXCD, off = wgid / NXCD; wgid = (xcd < r ? xcd * (q + 1) : r * (q + 1) + (xcd - r) * q) + off; }
        const int nig = WGM * nN, gid = wgid / nig, fm = gid * WGM, gsz = (nM - fm) < WGM ? (nM - fm) : WGM;
        u.pm = fm + ((wgid % nig) % gsz); u.pn = (wgid % nig) / gsz; return true;
    }
    __device__ __forceinline__ const char* aptr(const Unit& u) const { return ((NP == 1 || u.pass == 0) ? A[0] : A[NP - 1]) + (size_t)u.pm * tstep; }
    __device__ __forceinline__ const char* bptr(const Unit& u) const { return ((NP == 1 || u.pass == 0) ? B[0] : B[NP - 1]) + (size_t)u.pn * tstep; }
};

template <class Epi, class Sched>
__device__ __forceinline__ void gemm_phase(PG8_LAS unsigned char* lds, const int tid, const int K, const Sched& S, const Epi& E) {
    const int wid = __builtin_amdgcn_readfirstlane(tid >> 6), lane = tid & 63, wr = wid >> 2, wc = wid & 3, fr = lane & 15, fq = lane >> 4;
    const int nt = K / BK;
    unsigned voffA[2], voffB[2];
#pragma unroll
    for (int i = 0; i < 2; ++i) { int R, C; stage_rc(tid * 16 + i * 8192, R, C); const int Rb = (R & ~31) + perm32(R & 31);
        voffA[i] = (unsigned)(R * K + C) * 2u; voffB[i] = (unsigned)(Rb * K + C) * 2u; }
    const size_t kstep = (size_t)(BK * 2);
    const size_t hstep = (size_t)HALF * K * 2;
    const unsigned ldsw = (unsigned)wid * 1024u;
    const int aoff = lds_byte(wr * 64 + fr, fq * 8), boff = lds_byte(wc * 32 + fr, fq * 8);
#define PG8_SA(b, h) (((b) * 2 + (h)) * HTB)
#define PG8_SB(b, h) ((4 + (b) * 2 + (h)) * HTB)
#define PG8_STAGE(bufoff, gbase, voff) do { _Pragma("unroll") for (int _i = 0; _i < 2; ++_i) \
        __builtin_amdgcn_global_load_lds((const unsigned*)((const char*)(gbase) + (voff)[_i]), (PG8_LAS unsigned*)(lds + (bufoff) + ldsw + _i * 8192), 16, 0, 0); } while (0)
#define PG8_LDA(dst, b, h) do { _Pragma("unroll") for (int m = 0; m < 4; ++m) _Pragma("unroll") for (int k = 0; k < 2; ++k) dst[m][k] = *(const PG8_LAS bf16x8*)(lds + PG8_SA(b, h) + aoff + m * 2048 + k * 1024); } while (0)
#define PG8_LDB(dst, b, h) do { _Pragma("unroll") for (int n = 0; n < 2; ++n) _Pragma("unroll") for (int k = 0; k < 2; ++k) dst[n][k] = *(const PG8_LAS bf16x8*)(lds + PG8_SB(b, h) + boff + n * 2048 + k * 1024); } while (0)
#define PG8_MMA(ai, bj, At, Bt) do { __builtin_amdgcn_s_setprio(1); _Pragma("unroll") for (int m = 0; m < 4; ++m) _Pragma("unroll") for (int n = 0; n < 2; ++n) _Pragma("unroll") for (int k = 0; k < 2; ++k) \
        acc[ai][bj][m][n] = __builtin_amdgcn_mfma_f32_16x16x32_bf16(Bt[n][k], At[m][k], acc[ai][bj][m][n], 0, 0, 0); __builtin_amdgcn_s_setprio(0); } while (0)
#define PG8_WAIT_V(n) asm volatile("s_waitcnt vmcnt(" #n ")" ::: "memory")
#define PG8_WAIT_L(n) asm volatile("s_waitcnt lgkmcnt(" #n ")" ::: "memory")
#define PG8_BAR __builtin_amdgcn_s_barrier()
#define PG8_SCHED __builtin_amdgcn_sched_barrier(0)
    Unit cur, nxt; int ui = 0;
    if (!S.next(0, cur)) return;
    f32x4 acc[2][2][4][2];
#pragma unroll
    for (int a = 0; a < 2; ++a)
#pragma unroll
        for (int b = 0; b < 2; ++b)
#pragma unroll
            for (int m = 0; m < 4; ++m)
#pragma unroll
                for (int n = 0; n < 2; ++n) acc[a][b][m][n] = (f32x4){0.f, 0.f, 0.f, 0.f};
    bf16x8 At[4][2], B0[2][2], B1[2][2];
    const char* cA = S.aptr(cur); const char* cB = S.bptr(cur);
    PG8_STAGE(PG8_SB(0, 0), cB, voffB); PG8_STAGE(PG8_SB(0, 1), cB + hstep, voffB); PG8_STAGE(PG8_SA(0, 0), cA, voffA); PG8_STAGE(PG8_SA(0, 1), cA + hstep, voffA);
    if (wr == 1) PG8_BAR;
    PG8_WAIT_V(2); PG8_BAR;
    PG8_STAGE(PG8_SB(1, 0), cB + kstep, voffB); PG8_STAGE(PG8_SA(1, 0), cA + kstep, voffA); PG8_STAGE(PG8_SB(1, 1), cB + hstep + kstep, voffB);
    PG8_WAIT_V(6); PG8_BAR;
    for (;;) {
        const bool has_next = S.next(ui + 1, nxt);
        const char* nA = has_next ? S.aptr(nxt) : cA; const char* nB = has_next ? S.bptr(nxt) : cB;
#pragma nounroll
        for (int t = 0; t < nt; t += 2) {
            const bool last = (t == nt - 2);
            const char* a1 = cA + (size_t)(t + 1) * kstep;
            const char* a2 = last ? nA : cA + (size_t)(t + 2) * kstep; const char* b2 = last ? nB : cB + (size_t)(t + 2) * kstep;
            const char* a3 = a2 + kstep; const char* b3 = b2 + kstep;
            PG8_LDB(B0, 0, 0); PG8_LDB(B1, 0, 1); PG8_SCHED; PG8_LDA(At, 0, 0); PG8_STAGE(PG8_SA(1, 1), a1 + hstep, voffA);
            PG8_WAIT_V(8); PG8_WAIT_L(0); PG8_BAR; PG8_MMA(0, 0, At, B0); PG8_MMA(0, 1, At, B1); PG8_BAR; PG8_SCHED;
            PG8_LDA(At, 0, 1); PG8_STAGE(PG8_SB(0, 0), b2, voffB); PG8_STAGE(PG8_SB(0, 1), b2 + hstep, voffB); PG8_STAGE(PG8_SA(0, 0), a2, voffA);
            PG8_WAIT_V(8); PG8_WAIT_L(0); PG8_BAR; PG8_MMA(1, 0, At, B0); PG8_MMA(1, 1, At, B1); PG8_BAR; PG8_SCHED;
            PG8_LDB(B0, 1, 0); PG8_LDB(B1, 1, 1); PG8_SCHED; PG8_LDA(At, 1, 0); PG8_STAGE(PG8_SA(0, 1), a2 + hstep, voffA);
            PG8_WAIT_V(8); PG8_WAIT_L(0); PG8_BAR; PG8_MMA(0, 0, At, B0); PG8_MMA(0, 1, At, B1); PG8_BAR; PG8_SCHED;
            PG8_LDA(At, 1, 1); PG8_STAGE(PG8_SB(1, 0), b3, voffB); PG8_STAGE(PG8_SB(1, 1), b3 + hstep, voffB); PG8_STAGE(PG8_SA(1, 0), a3, voffA);
            PG8_WAIT_V(8); PG8_WAIT_L(0); PG8_BAR; PG8_MMA(1, 0, At, B0); PG8_MMA(1, 1, At, B1); PG8_BAR; PG8_SCHED;
        }
        if (wr == 0) PG8_BAR;
        E(acc, cur, wr, wc, fr, fq);
        if (!has_next) break;
#pragma unroll
        for (int a = 0; a < 2; ++a)
#pragma unroll
            for (int b = 0; b < 2; ++b)
#pragma unroll
                for (int m = 0; m < 4; ++m)
#pragma unroll
                    for (int n = 0; n < 2; ++n) acc[a][b][m][n] = (f32x4){0.f, 0.f, 0.f, 0.f};
        cur = nxt; cA = nA; cB = nB; ++ui;
        if (wr == 1) PG8_BAR;
    }
    PG8_WAIT_V(0);
    PG8_BAR;
#undef PG8_SA
#undef PG8_SB
#undef PG8_STAGE
#undef PG8_LDA
#undef PG8_LDB
#undef PG8_MMA
#undef PG8_WAIT_V
#undef PG8_WAIT_L
#undef PG8_BAR
#undef PG8_SCHED
}

typedef float f32x4_ __attribute__((ext_vector_type(4)));
struct EpiG1 {
    bf16 *pna, *prt, *pgt; const float* rstd;
    __device__ __forceinline__ void operator()(const f32x4 (&acc)[2][2][4][2], const Unit& u, int wr, int wc, int fr, int fq) const {
        bf16* base; int ld, colt, act;
        if (u.pn < 32) { base = pna; ld = LD_NA; colt = u.pn * BM; act = (u.pn >= 24) ? 1 : 0; }
        else if (u.pn < 56) { base = prt; ld = LD_RT; colt = (u.pn - 32) * BM; act = (u.pn >= 48) ? 1 : 0; }
        else { base = pgt; ld = LD_GT; colt = (u.pn - 56) * BM; act = 2; }
        const int row0 = u.pm * BM + wr * 64 + fr, col0 = colt + wc * 32 + 8 * fq;
        float rsv[2][4];
#pragma unroll
        for (int ai = 0; ai < 2; ++ai)
#pragma unroll
            for (int m = 0; m < 4; ++m) rsv[ai][m] = rstd[row0 + ai * HALF + m * 16];
#pragma unroll
        for (int ai = 0; ai < 2; ++ai)
#pragma unroll
            for (int m = 0; m < 4; ++m) { const int row = row0 + ai * HALF + m * 16; const float rs = rsv[ai][m]; bf16* rowp = base + (size_t)row * ld + col0;
#pragma unroll
                for (int bj = 0; bj < 2; ++bj) { f32x4 v0 = acc[ai][bj][m][0] * rs, v1 = acc[ai][bj][m][1] * rs;
                    if (act != 0) {
#pragma unroll
                        for (int j = 0; j < 4; ++j) { const float s0 = sigmoidf_(v0[j]), s1 = sigmoidf_(v1[j]); v0[j] = (act == 1) ? v0[j] * s0 : s0; v1[j] = (act == 1) ? v1[j] * s1 : s1; } }
                    v4u w; w.x = pk2(v0[0], v0[1]); w.y = pk2(v0[2], v0[3]); w.z = pk2(v1[0], v1[1]); w.w = pk2(v1[2], v1[3]);
                    *(v4u*)(rowp + bj * HALF) = w; } }
    }
};
struct EpiG2 {
    const bf16* pgt; bf16* T; bf16* mrg;
    __device__ __forceinline__ void operator()(const f32x4 (&acc)[2][2][4][2], const Unit& u, int wr, int wc, int fr, int fq) const {
        const int row0 = u.pm * BM + wr * 64 + fr, col0 = u.pn * BM + wc * 32 + 8 * fq;
#pragma unroll
        for (int ai = 0; ai < 2; ++ai)
#pragma unroll
            for (int m = 0; m < 4; ++m) { const int row = row0 + ai * HALF + m * 16;
#pragma unroll
                for (int bj = 0; bj < 2; ++bj) { const int col = col0 + bj * HALF;
                    const v4u gt = *(const v4u*)(pgt + (size_t)row * LD_GT + u.pass * DM + col);
                    f32x4 v0 = acc[ai][bj][m][0], v1 = acc[ai][bj][m][1];
                    v0[0] *= bflo(gt.x); v0[1] *= bfhi(gt.x); v0[2] *= bflo(gt.y); v0[3] *= bfhi(gt.y); v1[0] *= bflo(gt.z); v1[1] *= bfhi(gt.z); v1[2] *= bflo(gt.w); v1[3] *= bfhi(gt.w);
                    bf16* dst = T + (size_t)row * DM + col;
                    if (u.pass == 1) { const v4u t = *(const v4u*)dst;
                        v0[0] += bflo(t.x); v0[1] += bfhi(t.x); v0[2] += bflo(t.y); v0[3] += bfhi(t.y); v1[0] += bflo(t.z); v1[1] += bfhi(t.z); v1[2] += bflo(t.w); v1[3] += bfhi(t.w);
                        dst = mrg + (size_t)row * DM + col; }
                    v4u w; w.x = pk2(v0[0], v0[1]); w.y = pk2(v0[2], v0[3]); w.z = pk2(v1[0], v1[1]); w.w = pk2(v1[2], v1[3]);
                    *(v4u*)dst = w; }
                asm volatile("" ::: "memory"); }
    }
};
template <bool STATS> struct EpiStore {
    bf16* O; float* part;
    __device__ __forceinline__ void operator()(const f32x4 (&acc)[2][2][4][2], const Unit& u, int wr, int wc, int fr, int fq) const {
        const int row0 = u.pm * BM + wr * 64 + fr, col0 = u.pn * BM + wc * 32 + 8 * fq;
#pragma unroll
        for (int ai = 0; ai < 2; ++ai)
#pragma unroll
            for (int m = 0; m < 4; ++m) { const int row = row0 + ai * HALF + m * 16; float ss = 0.f;
#pragma unroll
                for (int bj = 0; bj < 2; ++bj) { const f32x4 v0 = acc[ai][bj][m][0], v1 = acc[ai][bj][m][1];
                    if (STATS) ss += (v0[0] * v0[0] + v0[1] * v0[1]) + (v0[2] * v0[2] + v0[3] * v0[3]) + (v1[0] * v1[0] + v1[1] * v1[1]) + (v1[2] * v1[2] + v1[3] * v1[3]);
                    v4u w; w.x = pk2(v0[0], v0[1]); w.y = pk2(v0[2], v0[3]); w.z = pk2(v1[0], v1[1]); w.w = pk2(v1[2], v1[3]);
                    *(v4u*)(O + (size_t)row * DM + col0 + bj * HALF) = w; }
                if (STATS) { ss += __shfl_xor(ss, 16); ss += __shfl_xor(ss, 32); if (fq == 0) part[(size_t)row * 64 + u.pn * 4 + wc] = ss; } }
    }
};
struct EpiG4 {
    float* xio; const bf16* E; bf16* xb; float* part;
    __device__ __forceinline__ void operator()(const f32x4 (&acc)[2][2][4][2], const Unit& u, int wr, int wc, int fr, int fq) const {
        const int row0 = u.pm * BM + wr * 64 + fr, col0 = u.pn * BM + wc * 32 + 8 * fq;
#pragma unroll
        for (int ai = 0; ai < 2; ++ai)
#pragma unroll
            for (int m = 0; m < 4; ++m) { const int row = row0 + ai * HALF + m * 16; float ss = 0.f;
#pragma unroll
                for (int bj = 0; bj < 2; ++bj) { const size_t off = (size_t)row * DM + col0 + bj * HALF;
                    const v4u e = *(const v4u*)(E + off); const f32x4 x0 = *(const f32x4*)(xio + off), x1 = *(const f32x4*)(xio + off + 4);
                    const f32x4 a0 = acc[ai][bj][m][0], a1 = acc[ai][bj][m][1]; f32x4 v0, v1;
                    v0[0] = x0[0] + sigmoidf_(a0[0]) * bflo(e.x); v0[1] = x0[1] + sigmoidf_(a0[1]) * bfhi(e.x); v0[2] = x0[2] + sigmoidf_(a0[2]) * bflo(e.y); v0[3] = x0[3] + sigmoidf_(a0[3]) * bfhi(e.y);
                    v1[0] = x1[0] + sigmoidf_(a1[0]) * bflo(e.z); v1[1] = x1[1] + sigmoidf_(a1[1]) * bfhi(e.z); v1[2] = x1[2] + sigmoidf_(a1[2]) * bflo(e.w); v1[3] = x1[3] + sigmoidf_(a1[3]) * bfhi(e.w);
                    ss += (v0[0] * v0[0] + v0[1] * v0[1]) + (v0[2] * v0[2] + v0[3] * v0[3]) + (v1[0] * v1[0] + v1[1] * v1[1]) + (v1[2] * v1[2] + v1[3] * v1[3]);
                    *(f32x4*)(xio + off) = v0; *(f32x4*)(xio + off + 4) = v1;
                    v4u w; w.x = pk2(v0[0], v0[1]); w.y = pk2(v0[2], v0[3]); w.z = pk2(v1[0], v1[1]); w.w = pk2(v1[2], v1[3]);
                    *(v4u*)(xb + off) = w; }
                ss += __shfl_xor(ss, 16); ss += __shfl_xor(ss, 32); if (fq == 0) part[(size_t)row * 64 + u.pn * 4 + wc] = ss;
                asm volatile("" ::: "memory"); }
    }
};
}

#define XB_TMO      128
#define XB_XCNT(j)  (256  + 64 * (j))
#define XB_XSUB(j)  (1280 + 64 * (j))
#define XB_XGEN(j)  (2304 + 64 * (j))
#define XB_TOP      3328
#define XB_TOPGEN   3392
#define XCD_BAR_WORDS 3456
#define XB_SPIN_CAP (1u << 22)
__device__ __forceinline__ unsigned xb_ld(unsigned* p)              { return __hip_atomic_load(p, __ATOMIC_RELAXED, __HIP_MEMORY_SCOPE_AGENT); }
__device__ __forceinline__ unsigned xb_add(unsigned* p, unsigned v) { return __hip_atomic_fetch_add(p, v, __ATOMIC_RELAXED, __HIP_MEMORY_SCOPE_AGENT); }
__device__ __forceinline__ unsigned xb_xcc_id() { return (unsigned)__builtin_amdgcn_s_getreg((3 << 11) | 20) & 0xFu; }
#define XB_SPIN(cond, bar) do { unsigned _sp = 0; while (cond) { __builtin_amdgcn_s_sleep(1); \
    if ((++_sp & 255u) == 0u) { if (xb_ld(&(bar)[XB_TMO])) break; if (_sp > XB_SPIN_CAP) { atomicAdd(&(bar)[XB_TMO], 1u); break; } } } } while (0)
struct XcdBarrier { unsigned* bar; unsigned x; volatile LAS unsigned* st; };
__device__ __forceinline__ XcdBarrier xcd_barrier_post(unsigned* bar, volatile LAS unsigned* st) {
    XcdBarrier b; b.bar = bar; b.x = xb_xcc_id(); b.st = st;
    if (threadIdx.x == 0) (void)xb_add(&bar[XB_XCNT(b.x)], 1u);
    return b;
}
__device__ __forceinline__ void xcd_barrier_complete(unsigned* bar, unsigned x, unsigned& nloc, unsigned& nx) {
    const unsigned G = gridDim.x * gridDim.y * gridDim.z;
    unsigned sum, cnt, mine, sp = 0u;
    for (;;) {
        sum = 0u; cnt = 0u; mine = 0u;
#pragma unroll
        for (unsigned j = 0; j < 16; ++j) { const unsigned c = xb_ld(&bar[XB_XCNT(j)]); sum += c; cnt += (c > 0u) ? 1u : 0u; mine = (j == x) ? c : mine; }
        if (sum == G) break;
        __builtin_amdgcn_s_sleep(1);
        if ((++sp & 255u) == 0u) { if (xb_ld(&bar[XB_TMO])) break; if (sp > XB_SPIN_CAP) { atomicAdd(&bar[XB_TMO], 1u); break; } }
    }
    nloc = mine > 0u ? mine : 1u; nx = cnt > 0u ? cnt : 1u;
}
__device__ __forceinline__ void xcd_barrier(const XcdBarrier& b) {
    asm volatile("s_waitcnt vmcnt(0)" ::: "memory");
    __syncthreads();
    if (threadIdx.x == 0) {
        unsigned* bar = b.bar;
        __builtin_amdgcn_s_waitcnt(0);
        unsigned nloc = b.st[0], nx = b.st[1];
        if (nloc == 0u) { xcd_barrier_complete(bar, b.x, nloc, nx); b.st[0] = nloc; b.st[1] = nx; }
        const unsigned old = xb_add(&bar[XB_XSUB(b.x)], 1u);
        const unsigned gen = old / nloc;
        if (old + 1u == (gen + 1u) * nloc) {
            __builtin_amdgcn_fence(__ATOMIC_RELEASE, "agent");
            asm volatile("s_waitcnt vmcnt(0)" ::: "memory");
            const unsigned og = xb_add(&bar[XB_TOP], 1u);
            const unsigned tg = og / nx;
            if (og + 1u == (tg + 1u) * nx) xb_add(&bar[XB_TOPGEN], 1u);
            else XB_SPIN(xb_ld(&bar[XB_TOPGEN]) == tg, bar);
            __builtin_amdgcn_fence(__ATOMIC_ACQUIRE, "agent");
            xb_add(&bar[XB_XGEN(b.x)], 1u);
            asm volatile("s_waitcnt vmcnt(0)" ::: "memory");
        } else {
            XB_SPIN(xb_ld(&bar[XB_XGEN(b.x)]) == gen, bar);
            __builtin_amdgcn_fence(__ATOMIC_ACQUIRE, "agent");
            asm volatile("s_waitcnt vmcnt(0)" ::: "memory");
        }
    }
    __syncthreads();
}

struct Args { const float* in[16]; float* out; unsigned char* ws; int ph_lo, ph_hi; };
struct Frame {
    LAS unsigned char* lds; unsigned char* ws; const float* xp; const float* xs; const float* prm; float* out;
    int tid, lane, wave, vcu, G, bx;
};
enum { I_XP = 0, I_XS, I_PP, I_PS, I_WIN, I_LNPRE, I_LNPOST, I_RPB, I_LDF, I_LDB, I_GN, I_WPA, I_WPB, I_WOUT, I_WPLE, I_WG };

__device__ __forceinline__ void p0_transpose_item(const float* W, int K, int N, bf16* WT, const float* scale, LAS float* scr, int item, int lane) {
    const int nblk = N / 32, kb = item / nblk, nb = item % nblk, k0 = 64 * kb, n0 = 32 * nb;
#pragma unroll 8
    for (int i = 0; i < 32; ++i) { const int kk = 2 * i + (lane >> 5); float v = W[(size_t)(k0 + kk) * N + n0 + (lane & 31)]; if (scale) v *= scale[k0 + kk]; scr[kk * 33 + (lane & 31)] = v; }
    LDS_WAIT(); asm volatile("" ::: "memory");
    const int c = lane & 7;
#pragma unroll
    for (int j = 0; j < 4; ++j) { const int n = (lane >> 3) + 8 * j; const LAS float* s = scr + (8 * c) * 33 + n;
        v4u o; o.x = pk2(s[0 * 33], s[1 * 33]); o.y = pk2(s[2 * 33], s[3 * 33]); o.z = pk2(s[4 * 33], s[5 * 33]); o.w = pk2(s[6 * 33], s[7 * 33]);
        *(v4u*)(WT + (size_t)(n0 + n) * K + k0 + 8 * c) = o; }
    LDS_WAIT(); asm volatile("" ::: "memory");
}
__device__ __forceinline__ void p0_prologue(Frame& F, const Args& A) {
    LAS float* scr = (LAS float*)(F.lds + F.wave * 16384);
    const int gw = F.vcu * 8 + F.wave, NGW = F.G * 8;
    constexpr int I_IN = (DM / 64) * (INW / 32), I_PA = (2048 / 64) * (DM / 32), I_O = (DM / 64) * (DM / 32), I_PL = (PLE / 64) * (DM / 32);
    constexpr int PER_L = I_IN + 2 * I_PA + 2 * I_O + I_PL;
    for (int it = gw; it < 2 * PER_L; it += NGW) {
        const int L = it / PER_L; int r = it - L * PER_L;
        if (r < I_IN) { p0_transpose_item(A.in[I_WIN] + (size_t)L * DM * INW, DM, INW, (bf16*)(F.ws + WS_WIN) + (size_t)L * INW * DM, A.in[I_LNPRE] + L * DM, scr, r, F.lane); continue; } r -= I_IN;
        if (r < I_PA) { p0_transpose_item(A.in[I_WPA] + (size_t)L * 2048 * DM, 2048, DM, (bf16*)(F.ws + WS_WPA) + (size_t)L * DM * 2048, nullptr, scr, r, F.lane); continue; } r -= I_PA;
        if (r < I_PA) { p0_transpose_item(A.in[I_WPB] + (size_t)L * 2048 * DM, 2048, DM, (bf16*)(F.ws + WS_WPB) + (size_t)L * DM * 2048, nullptr, scr, r, F.lane); continue; } r -= I_PA;
        if (r < I_O) { p0_transpose_item(A.in[I_WOUT] + (size_t)L * DM * DM, DM, DM, (bf16*)(F.ws + WS_WOUT) + (size_t)L * DM * DM, nullptr, scr, r, F.lane); continue; } r -= I_O;
        if (r < I_O) { p0_transpose_item(A.in[I_WG] + (size_t)L * DM * DM, DM, DM, (bf16*)(F.ws + WS_WG) + (size_t)L * DM * DM, nullptr, scr, r, F.lane); continue; } r -= I_O;
        p0_transpose_item(A.in[I_WPLE] + (size_t)L * PLE * DM, PLE, DM, (bf16*)(F.ws + WS_WPLE) + (size_t)L * DM * PLE, nullptr, scr, r, F.lane);
    }
    float* rstd = (float*)(F.ws + WS_RSTD); bf16* xb = (bf16*)(F.ws + WS_XBA);
    for (int m = gw; m < NTOK; m += NGW) {
        const float* xr = (m < NTOK_P) ? A.in[I_XP] + (size_t)m * DM : A.in[I_XS] + (size_t)(m - NTOK_P) * DM;
        float s = 0.f;
#pragma unroll 4
        for (int j = 0; j < 16; ++j) { const f32x4 v = *(const f32x4*)(xr + j * 256 + F.lane * 4); s += (v[0] * v[0] + v[1] * v[1]) + (v[2] * v[2] + v[3] * v[3]);
            v2u w; w.x = pk2(v[0], v[1]); w.y = pk2(v[2], v[3]); *(v2u*)(xb + (size_t)m * DM + j * 256 + F.lane * 4) = w; }
        s = wave_sum(s);
        if (F.lane == 0) rstd[m] = 1.0f / sqrtf(s * (1.0f / DM) + EPS);
    }
    bf16* pb = (bf16*)(F.ws + WS_PB);
    for (int i = gw * 64 + F.lane; i < 2 * NTOK * (PLE / 4); i += NGW * 64) {
        const int L = i / (NTOK * (PLE / 4)), r = i - L * (NTOK * (PLE / 4)), m = r / (PLE / 4), c4 = r % (PLE / 4);
        const float* src = (m < NTOK_P) ? A.in[I_PP] + ((size_t)L * NTOK_P + m) * PLE : A.in[I_PS] + ((size_t)L * (NTOK - NTOK_P) + (m - NTOK_P)) * PLE;
        const f32x4 v = *(const f32x4*)(src + c4 * 4); v2u w; w.x = pk2(v[0], v[1]); w.y = pk2(v[2], v[3]);
        *(v2u*)(pb + ((size_t)L * NTOK + m) * PLE + c4 * 4) = w;
    }
    { float* prm = (float*)(F.ws + WS_PRM);
      for (int i = gw * 64 + F.lane; i < PRM_N; i += NGW * 64) {
          float v;
          if (i < PRM_LDF) v = A.in[I_RPB][i]; else if (i < PRM_LDB) v = A.in[I_LDF][i - PRM_LDF]; else if (i < PRM_GN) v = A.in[I_LDB][i - PRM_LDB];
          else if (i < PRM_LNPOST) v = A.in[I_GN][i - PRM_GN]; else v = A.in[I_LNPOST][i - PRM_LNPOST];
          prm[i] = v; } }
    float* ct = (float*)(F.ws + WS_COS); float* st = (float*)(F.ws + WS_SIN);
    for (int i = gw * 64 + F.lane; i < SEQ * 64; i += NGW * 64) {
        const int pos = i >> 6, k = i & 63;
        const float inv = __builtin_amdgcn_exp2f(-(float)k * 0.20762050593046014f);
        const float ang = (float)pos * inv;
        const float n = rintf(ang * 0.15915494f);
        const float fr_ = __builtin_fmaf(ang, 0.15915494f, -n) + ang * 6.4206e-9f;
        ct[i] = __builtin_amdgcn_cosf(fr_); st[i] = __builtin_amdgcn_sinf(fr_);
    }
}

__device__ __forceinline__ void rot_phase(Frame& F) {
    bf16* prt = (bf16*)(F.ws + WS_PRT); const float* ct = (const float*)(F.ws + WS_COS); const float* st = (const float*)(F.ws + WS_SIN);
    const int gt = (F.vcu * 8 + F.wave) * 64 + F.lane, NT = F.G * 512;
    for (int i = gt; i < NTOK * 128; i += NT) {
        const int m = i >> 7, r = i & 127, which = r >> 6, h = (r >> 3) & 7, c = r & 7, pos = m & (SEQ - 1);
        bf16* p = prt + (size_t)m * LD_RT + which * 1024 + h * 128 + c * 8;
        const v4u lo = *(const v4u*)p, hi = *(const v4u*)(p + 64);
        const f32x4 c0 = *(const f32x4*)(ct + pos * 64 + c * 8), c1 = *(const f32x4*)(ct + pos * 64 + c * 8 + 4);
        const f32x4 s0 = *(const f32x4*)(st + pos * 64 + c * 8), s1 = *(const f32x4*)(st + pos * 64 + c * 8 + 4);
        const float sc = which ? 0.08838834764831845f : 1.0f;
        float a[8] = {bflo(lo.x), bfhi(lo.x), bflo(lo.y), bfhi(lo.y), bflo(lo.z), bfhi(lo.z), bflo(lo.w), bfhi(lo.w)};
        float b[8] = {bflo(hi.x), bfhi(hi.x), bflo(hi.y), bfhi(hi.y), bflo(hi.z), bfhi(hi.z), bflo(hi.w), bfhi(hi.w)};
        const float cs[8] = {c0[0], c0[1], c0[2], c0[3], c1[0], c1[1], c1[2], c1[3]}, sn[8] = {s0[0], s0[1], s0[2], s0[3], s1[0], s1[1], s1[2], s1[3]};
        float ol[8], oh[8];
#pragma unroll
        for (int j = 0; j < 8; ++j) { ol[j] = (a[j] * cs[j] - b[j] * sn[j]) * sc; oh[j] = (a[j] * sn[j] + b[j] * cs[j]) * sc; }
        v4u wl, wh; wl.x = pk2(ol[0], ol[1]); wl.y = pk2(ol[2], ol[3]); wl.z = pk2(ol[4], ol[5]); wl.w = pk2(ol[6], ol[7]);
        wh.x = pk2(oh[0], oh[1]); wh.y = pk2(oh[2], oh[3]); wh.z = pk2(oh[4], oh[5]); wh.w = pk2(oh[6], oh[7]);
        *(v4u*)p = wl; *(v4u*)(p + 64) = wh;
    }
}

constexpr int NA_VSTRIDE = 288;
constexpr int NA_BIAS_OFF = 0, NA_V_OFF = 4096, NA_VROW = 64 * NA_VSTRIDE;
__device__ __forceinline__ void na_phase(Frame& F, int L) {
    const bf16* pna = (const bf16*)(F.ws + WS_PNA); bf16* ao = (bf16*)(F.ws + WS_AO);
    const float* rpb = F.prm + PRM_RPB + (size_t)L * 16 * 465;
    const int lane = F.lane, fr0 = lane & 15, g0 = lane >> 4, usub = F.wave >> 2, qblk = F.wave & 3;
    LAS float* lb = (LAS float*)(F.lds + NA_BIAS_OFF);
    const unsigned vlds = (unsigned)(size_t)(F.lds + NA_V_OFF);
    const float scale = 0.08838834764831845f;
    for (int up = F.vcu; up < NSEQ * 64 * 8; up += F.G) {
        int fr = fr0, g = g0; asm volatile("" : "+v"(fr), "+v"(g));
        const int b = up >> 9, hp = (up >> 6) & 7, r = up & 63, h = 2 * hp + usub;
        const int rs = min(max(r - 4, 0), 56);
        const int tokq = b * SEQ + r * 64 + 16 * qblk + fr;
        for (int i = F.tid; i < 2 * 465; i += 512) lb[(i >= 465 ? 512 : 0) + (i >= 465 ? i - 465 : i)] = rpb[(size_t)(2 * hp) * 465 + i];
        bf16x8 Qf[4];
#pragma unroll
        for (int ks = 0; ks < 4; ++ks) Qf[ks] = *(const bf16x8*)(pna + (size_t)tokq * LD_NA + h * 128 + 32 * ks + 8 * g);
        const int kc0 = min(max(16 * qblk - 8, 0), 32);
        f32x4 S[16];
#pragma unroll
        for (int kb = 0; kb < 16; ++kb) {
            const int wr = kb >> 1, cb = kb & 1;
            const bf16* kp = pna + (size_t)(b * SEQ + (rs + wr) * 64 + kc0 + 16 * cb + fr) * LD_NA + 2048 + h * 128 + 8 * g;
            bf16x8 Kf[4];
#pragma unroll
            for (int ks = 0; ks < 4; ++ks) Kf[ks] = *(const bf16x8*)(kp + 32 * ks);
            f32x4 a = (f32x4){0.f, 0.f, 0.f, 0.f};
#pragma unroll
            for (int ks = 0; ks < 4; ++ks) a = MFMA16(Kf[ks], Qf[ks], a);
            S[kb] = a;
        }
        __syncthreads();
        const int c = 16 * qblk + fr, cs = min(max(c - 8, 0), 48);
        const LAS float* lbh = lb + usub * 512;
        float mx = -3.0e38f;
#pragma unroll
        for (int kb = 0; kb < 16; ++kb) {
            const int wr = kb >> 1, cb = kb & 1;
#pragma unroll
            for (int e = 0; e < 4; ++e) {
                const int kc = kc0 + 16 * cb + 4 * g + e; const bool valid = (kc >= cs) && (kc < cs + 16);
                const int bi = (rs + wr - r + 7) * 31 + (kc - c + 15);
                const float bias = valid ? lbh[bi] : 0.f;
                const float s = valid ? S[kb][e] * scale + bias : -3.0e38f;
                S[kb][e] = s; mx = fmaxf(mx, s);
            }
        }
        mx = fmaxf(mx, __shfl_xor(mx, 16)); mx = fmaxf(mx, __shfl_xor(mx, 32));
        float sum = 0.f;
#pragma unroll
        for (int kb = 0; kb < 16; ++kb)
#pragma unroll
            for (int e = 0; e < 4; ++e) { const float p = (S[kb][e] > -1.0e38f) ? expf_(S[kb][e] - mx) : 0.f; S[kb][e] = p; sum += p; }
        sum += __shfl_xor(sum, 16); sum += __shfl_xor(sum, 32);
        const float inv = 1.0f / sum;
        bf16x8 Pf[8];
#pragma unroll
        for (int wr = 0; wr < 8; ++wr) { v4u w; w.x = pk2(S[2 * wr][0], S[2 * wr][1]); w.y = pk2(S[2 * wr][2], S[2 * wr][3]); w.z = pk2(S[2 * wr + 1][0], S[2 * wr + 1][1]); w.w = pk2(S[2 * wr + 1][2], S[2 * wr + 1][3]);
            Pf[wr] = __builtin_bit_cast(bf16x8, w); }
        f32x4 O[8];
#pragma unroll
        for (int db = 0; db < 8; ++db) O[db] = (f32x4){0.f, 0.f, 0.f, 0.f};
#pragma unroll
        for (int stg = 0; stg < 2; ++stg) {
#pragma unroll
            for (int hb = 0; hb < 2; ++hb) {
                v4u tmp[8];
#pragma unroll
                for (int i = 0; i < 8; ++i) { const int idx = F.tid + 512 * (hb * 8 + i), ch = idx & 15, col = (idx >> 4) & 63, rw = (idx >> 10) & 3, us = idx >> 12;
                    tmp[i] = *(const v4u*)(pna + (size_t)(b * SEQ + (rs + 4 * stg + rw) * 64 + col) * LD_NA + 4096 + (2 * hp + us) * 128 + ch * 8); }
#pragma unroll
                for (int i = 0; i < 8; ++i) { const int idx = F.tid + 512 * (hb * 8 + i), ch = idx & 15, col = (idx >> 4) & 63, rw = (idx >> 10) & 3, us = idx >> 12;
                    *(LAS v4u*)(F.lds + NA_V_OFF + (us * 4 + rw) * NA_VROW + col * NA_VSTRIDE + ch * 16) = tmp[i]; }
            }
            __syncthreads();
#pragma unroll
            for (int rw = 0; rw < 4; ++rw) {
                const int wr = 4 * stg + rw;
                const unsigned base = vlds + (usub * 4 + rw) * NA_VROW + (kc0 + 4 * g + (fr >> 2)) * NA_VSTRIDE + (fr & 3) * 8;
#pragma unroll
                for (int db = 0; db < 8; db += 2) {
                    bf16x8 V0, V1;
                    tr2x2(V0, V1, base + db * 32, base + db * 32 + 16 * NA_VSTRIDE, base + db * 32 + 32, base + db * 32 + 32 + 16 * NA_VSTRIDE);
                    O[db] = MFMA16(V0, Pf[wr], O[db]); O[db + 1] = MFMA16(V1, Pf[wr], O[db + 1]);
                }
            }
            __syncthreads();
        }
#pragma unroll
        for (int db = 0; db < 8; ++db) {
            const v2u gt = *(const v2u*)(pna + (size_t)tokq * LD_NA + 6144 + h * 128 + 16 * db + 4 * g);
            v2u w; w.x = pk2(O[db][0] * inv * bflo(gt.x), O[db][1] * inv * bfhi(gt.x)); w.y = pk2(O[db][2] * inv * bflo(gt.y), O[db][3] * inv * bfhi(gt.y));
            *(v2u*)(ao + (size_t)tokq * 2048 + h * 128 + 16 * db + 4 * g) = w;
        }
    }
}

constexpr int SC_KSTRIDE = 288, SC_VSTRIDE = 96, SC_K_OFF = 0, SC_V_OFF = 128 * SC_KSTRIDE;
__device__ __forceinline__ void scan_phase(Frame& F, int L) {
    const bf16* prt = (const bf16*)(F.ws + WS_PRT); bf16* kvs = (bf16*)(F.ws + WS_KVS);
    const int lane = F.lane, fr0 = lane & 15, g0 = lane >> 4, w = F.wave;
    const unsigned klds = (unsigned)(size_t)(F.lds + SC_K_OFF), vldsb = (unsigned)(size_t)(F.lds + SC_V_OFF);
    for (int t = F.vcu; t < NSEQ * 8 * 2 * 8; t += F.G) {
        const int dvs = t & 7, dir = (t >> 3) & 1, h = (t >> 4) & 7, b = t >> 7;
        const float ld = -fabsf(F.prm[(dir ? PRM_LDB : PRM_LDF) + L * 8 + h]);
        const float cd = expf_(ld * 128.0f);
        f32x4 acc[2]; acc[0] = (f32x4){0.f, 0.f, 0.f, 0.f}; acc[1] = acc[0];
#pragma nounroll
        for (int step = 0; step < 32; ++step) {
            int fr = fr0, g = g0; asm volatile("" : "+v"(fr), "+v"(g));
            const int n = dir ? 31 - step : step; const int tokbase = b * SEQ + n * 128;
            v4u kt[4];
#pragma unroll
            for (int i = 0; i < 4; ++i) { const int idx = F.tid + 512 * i, ch = idx & 15, tok = idx >> 4;
                kt[i] = *(const v4u*)(prt + (size_t)(tokbase + tok) * LD_RT + 1024 + h * 128 + ch * 8); }
            const v4u vt = *(const v4u*)(prt + (size_t)(tokbase + (F.tid >> 2)) * LD_RT + 2048 + h * 256 + dvs * 32 + (F.tid & 3) * 8);
#pragma unroll
            for (int i = 0; i < 4; ++i) { const int idx = F.tid + 512 * i, ch = idx & 15, tok = idx >> 4;
                const float f = expf_(ld * (float)(dir ? tok : 127 - tok));
                v4u o; o.x = pk2(bflo(kt[i].x) * f, bfhi(kt[i].x) * f); o.y = pk2(bflo(kt[i].y) * f, bfhi(kt[i].y) * f); o.z = pk2(bflo(kt[i].z) * f, bfhi(kt[i].z) * f); o.w = pk2(bflo(kt[i].w) * f, bfhi(kt[i].w) * f);
                *(LAS v4u*)(F.lds + SC_K_OFF + tok * SC_KSTRIDE + ch * 16) = o; }
            *(LAS v4u*)(F.lds + SC_V_OFF + (F.tid >> 2) * SC_VSTRIDE + (F.tid & 3) * 16) = vt;
            __syncthreads();
            bf16* kout = kvs + ((size_t)(((b * 8 + h) * 2 + dir) * 32 + n) * 256) * 128;
#pragma unroll
            for (int blk = 0; blk < 2; ++blk) { v2u o; o.x = pk2(acc[blk][0], acc[blk][1]); o.y = pk2(acc[blk][2], acc[blk][3]);
                *(v2u*)(kout + (size_t)(dvs * 32 + 16 * blk + fr) * 128 + 16 * w + 4 * g) = o; }
            acc[0] *= cd; acc[1] *= cd;
#pragma unroll
            for (int ks = 0; ks < 4; ++ks) {
                const unsigned row = 32 * ks + 8 * g + (fr >> 2);
                const unsigned ka = klds + row * SC_KSTRIDE + (16 * w + 4 * (fr & 3)) * 2;
                const unsigned va = vldsb + row * SC_VSTRIDE + (4 * (fr & 3)) * 2;
                const bf16x8 Af = tr2(ka, ka + 4 * SC_KSTRIDE);
                bf16x8 B0, B1; tr2x2(B0, B1, va, va + 4 * SC_VSTRIDE, va + 32, va + 32 + 4 * SC_VSTRIDE);
                acc[0] = MFMA16(Af, B0, acc[0]); acc[1] = MFMA16(Af, B1, acc[1]);
            }
            __syncthreads();
        }
    }
}

constexpr int RO_QSTRIDE = 272, RO_VSTRIDE = 544, RO_Q_OFF = 0, RO_P_OFF = 128 * RO_QSTRIDE, RO_V_OFF = 2 * 128 * RO_QSTRIDE, RO_RED_OFF = RO_V_OFF + 128 * RO_VSTRIDE;
__device__ __forceinline__ void rout_phase(Frame& F, int L) {
    const bf16* prt = (const bf16*)(F.ws + WS_PRT); const bf16* kvs = (const bf16*)(F.ws + WS_KVS); bf16* bo = (bf16*)(F.ws + WS_BO);
    const int lane = F.lane, fr0 = lane & 15, g0 = lane >> 4, w = F.wave;
    const unsigned vlds = (unsigned)(size_t)(F.lds + RO_V_OFF);
    LAS float* red = (LAS float*)(F.lds + RO_RED_OFF);
    for (int u = F.vcu; u < NSEQ * 8 * 32; u += F.G) {
        int fr = fr0, g = g0, tid = F.tid; asm volatile("" : "+v"(fr), "+v"(g), "+v"(tid));
        const int n = u & 31, h = (u >> 5) & 7, b = u >> 8; const int tokbase = b * SEQ + n * 128;
        const float ldf = -fabsf(F.prm[PRM_LDF + L * 8 + h]), ldb = -fabsf(F.prm[PRM_LDB + L * 8 + h]);
        {
            v4u q[4], v[8];
#pragma unroll
            for (int i = 0; i < 4; ++i) { const int idx = tid + 512 * i, ch = idx & 15, tok = idx >> 4; q[i] = *(const v4u*)(prt + (size_t)(tokbase + tok) * LD_RT + h * 128 + ch * 8); }
#pragma unroll
            for (int i = 0; i < 8; ++i) { const int idx = tid + 512 * i, ch = idx & 31, tok = idx >> 5; v[i] = *(const v4u*)(prt + (size_t)(tokbase + tok) * LD_RT + 2048 + h * 256 + ch * 8); }
#pragma unroll
            for (int i = 0; i < 4; ++i) { const int idx = tid + 512 * i, ch = idx & 15, tok = idx >> 4; *(LAS v4u*)(F.lds + RO_Q_OFF + tok * RO_QSTRIDE + ch * 16) = q[i]; }
#pragma unroll
            for (int i = 0; i < 8; ++i) { const int idx = tid + 512 * i, ch = idx & 31, tok = idx >> 5; *(LAS v4u*)(F.lds + RO_V_OFF + tok * RO_VSTRIDE + ch * 16) = v[i]; }
        }
        bf16x8 Kf[4];
#pragma unroll
        for (int ks = 0; ks < 4; ++ks) Kf[ks] = *(const bf16x8*)(prt + (size_t)(tokbase + 16 * w + fr) * LD_RT + 1024 + h * 128 + 32 * ks + 8 * g);
        __syncthreads();
#pragma unroll
        for (int tb = 0; tb < 8; ++tb) {
            f32x4 s = (f32x4){0.f, 0.f, 0.f, 0.f};
#pragma unroll
            for (int ks = 0; ks < 4; ++ks) { const bf16x8 Qf = *(const LAS bf16x8*)(F.lds + RO_Q_OFF + (16 * tb + fr) * RO_QSTRIDE + (32 * ks + 8 * g) * 2); s = MFMA16(Kf[ks], Qf, s); }
            const int c = 16 * tb + fr; float p[4];
#pragma unroll
            for (int e = 0; e < 4; ++e) { const int sk = 16 * w + 4 * g + e; const int d = c - sk;
                const float dm = (d > 0) ? expf_(ldf * (float)d) : ((d < 0) ? expf_(ldb * (float)(-d)) : 2.0f);
                p[e] = s[e] * dm; }
            v2u o; o.x = pk2(p[0], p[1]); o.y = pk2(p[2], p[3]);
            *(LAS v2u*)(F.lds + RO_P_OFF + c * RO_QSTRIDE + (16 * w + 4 * g) * 2) = o;
            asm volatile("" ::: "memory");
        }
        f32x4 acc[2][8];
        {
            bf16x8 PF[2][4];
            const bf16* kf = kvs + ((size_t)(((b * 8 + h) * 2 + 0) * 32 + n) * 256) * 128;
#pragma unroll
            for (int blk = 0; blk < 2; ++blk)
#pragma unroll
                for (int ks = 0; ks < 4; ++ks) PF[blk][ks] = *(const bf16x8*)(kf + (size_t)(32 * w + 16 * blk + fr) * 128 + 32 * ks + 8 * g);
#pragma unroll
            for (int tb = 0; tb < 8; ++tb) {
                bf16x8 Qf[4];
#pragma unroll
                for (int ks = 0; ks < 4; ++ks) Qf[ks] = *(const LAS bf16x8*)(F.lds + RO_Q_OFF + (16 * tb + fr) * RO_QSTRIDE + (32 * ks + 8 * g) * 2);
                const int c = 16 * tb + fr; const float ratio = expf_(ldf * (float)(c + 1) - ldb * (float)(128 - c));
#pragma unroll
                for (int blk = 0; blk < 2; ++blk) {
                    f32x4 a = (f32x4){0.f, 0.f, 0.f, 0.f};
#pragma unroll
                    for (int ks = 0; ks < 4; ++ks) a = MFMA16(PF[blk][ks], Qf[ks], a);
                    acc[blk][tb] = a * ratio;
                }
                asm volatile("" ::: "memory");
            }
        }
        {
            bf16x8 PBk[2][4];
            const bf16* kb = kvs + ((size_t)(((b * 8 + h) * 2 + 1) * 32 + n) * 256) * 128;
#pragma unroll
            for (int blk = 0; blk < 2; ++blk)
#pragma unroll
                for (int ks = 0; ks < 4; ++ks) PBk[blk][ks] = *(const bf16x8*)(kb + (size_t)(32 * w + 16 * blk + fr) * 128 + 32 * ks + 8 * g);
#pragma unroll
            for (int tb = 0; tb < 8; ++tb) {
                bf16x8 Qf[4];
#pragma unroll
                for (int ks = 0; ks < 4; ++ks) Qf[ks] = *(const LAS bf16x8*)(F.lds + RO_Q_OFF + (16 * tb + fr) * RO_QSTRIDE + (32 * ks + 8 * g) * 2);
                const int c = 16 * tb + fr; const float eb = expf_(ldb * (float)(128 - c));
#pragma unroll
                for (int blk = 0; blk < 2; ++blk) {
                    f32x4 a = acc[blk][tb];
#pragma unroll
                    for (int ks = 0; ks < 4; ++ks) a = MFMA16(PBk[blk][ks], Qf[ks], a);
                    acc[blk][tb] = a * eb;
                }
                asm volatile("" ::: "memory");
            }
        }
        __syncthreads();
#pragma unroll
        for (int kk = 0; kk < 4; ++kk) {
            const unsigned va = vlds + (32 * kk + 8 * g + (fr >> 2)) * RO_VSTRIDE + (32 * w + 4 * (fr & 3)) * 2;
            bf16x8 V0, V1; tr2x2(V0, V1, va, va + 4 * RO_VSTRIDE, va + 32, va + 32 + 4 * RO_VSTRIDE);
#pragma unroll
            for (int tb = 0; tb < 8; ++tb) {
                const bf16x8 Pf = *(const LAS bf16x8*)(F.lds + RO_P_OFF + (16 * tb + fr) * RO_QSTRIDE + (32 * kk + 8 * g) * 2);
                acc[0][tb] = MFMA16(V0, Pf, acc[0][tb]); acc[1][tb] = MFMA16(V1, Pf, acc[1][tb]);
            }
        }
#pragma unroll
        for (int tb = 0; tb < 8; ++tb) {
            float ss = 0.f;
#pragma unroll
            for (int blk = 0; blk < 2; ++blk) { const f32x4 a = acc[blk][tb]; ss += (a[0] * a[0] + a[1] * a[1]) + (a[2] * a[2] + a[3] * a[3]); }
            ss += __shfl_xor(ss, 16); ss += __shfl_xor(ss, 32);
            if (g == 0) red[w * 128 + 16 * tb + fr] = ss;
        }
        __syncthreads();
        const float* gn = F.prm + PRM_GN + (size_t)L * 2048 + h * 256;
        f32x4 gnv[2];
#pragma unroll
        for (int blk = 0; blk < 2; ++blk) gnv[blk] = *(const f32x4*)(gn + 32 * w + 16 * blk + 4 * g);
#pragma unroll
        for (int tb = 0; tb < 8; ++tb) {
            const int c = 16 * tb + fr; float tot = 0.f;
#pragma unroll
            for (int ww = 0; ww < 8; ++ww) tot += red[ww * 128 + c];
            const float rinv = 1.0f / sqrtf(tot * (1.0f / 256.0f) + EPS);
#pragma unroll
            for (int blk = 0; blk < 2; ++blk) {
                const int dv = 32 * w + 16 * blk + 4 * g;
                const v2u gt = *(const v2u*)(prt + (size_t)(tokbase + c) * LD_RT + 4096 + h * 256 + dv);
                const f32x4 a = acc[blk][tb];
                v2u o; o.x = pk2(a[0] * rinv * gnv[blk][0] * bflo(gt.x), a[1] * rinv * gnv[blk][1] * bfhi(gt.x)); o.y = pk2(a[2] * rinv * gnv[blk][2] * bflo(gt.y), a[3] * rinv * gnv[blk][3] * bfhi(gt.y));
                *(v2u*)(bo + (size_t)(tokbase + c) * 2048 + h * 256 + dv) = o;
            }
        }
        __syncthreads();
    }
}

__device__ __forceinline__ void p6_phase(Frame& F, int L) {
    const bf16* y = (const bf16*)(F.ws + WS_Y); const float* part = (const float*)(F.ws + WS_PART); bf16* xb = (bf16*)(F.ws + WS_XBB);
    const float* lnp = F.prm + PRM_LNPOST + (size_t)L * DM;
    const int gw = F.vcu * 8 + F.wave, NGW = F.G * 8;
    for (int m = gw; m < NTOK; m += NGW) {
        const float ss = wave_sum(part[(size_t)m * 64 + F.lane]);
        const float rs = 1.0f / sqrtf(ss * (1.0f / DM) + EPS);
        const float* xr = (L == 0) ? ((m < NTOK_P) ? F.xp + (size_t)m * DM : F.xs + (size_t)(m - NTOK_P) * DM) : F.out + (size_t)m * DM;
#pragma unroll 4
        for (int j = 0; j < 16; ++j) { const int col = j * 256 + F.lane * 4;
            const f32x4 xv = *(const f32x4*)(xr + col), gv = *(const f32x4*)(lnp + col); const v2u yv = *(const v2u*)(y + (size_t)m * DM + col);
            f32x4 o; o[0] = xv[0] + bflo(yv.x) * rs * gv[0]; o[1] = xv[1] + bfhi(yv.x) * rs * gv[1]; o[2] = xv[2] + bflo(yv.y) * rs * gv[2]; o[3] = xv[3] + bfhi(yv.y) * rs * gv[3];
            *(f32x4*)(F.out + (size_t)m * DM + col) = o;
            v2u w; w.x = pk2(o[0], o[1]); w.y = pk2(o[2], o[3]); *(v2u*)(xb + (size_t)m * DM + col) = w; }
    }
}
__device__ __forceinline__ void rstd_phase(Frame& F) {
    const float* part = (const float*)(F.ws + WS_PART2); float* rstd = (float*)(F.ws + WS_RSTD);
    const int gw = F.vcu * 8 + F.wave, NGW = F.G * 8;
    for (int m = gw; m < NTOK; m += NGW) { const float ss = wave_sum(part[(size_t)m * 64 + F.lane]); if (F.lane == 0) rstd[m] = 1.0f / sqrtf(ss * (1.0f / DM) + EPS); }
}

constexpr int NPH = 18;
__global__ void __launch_bounds__(512, 2) fwd(Args args) {
    extern __shared__ __attribute__((aligned(16))) unsigned char lds_raw[];
    Frame F;
    F.lds = (LAS unsigned char*)lds_raw; F.ws = args.ws; F.out = args.out; F.xp = args.in[I_XP]; F.xs = args.in[I_XS]; F.prm = (const float*)(args.ws + WS_PRM);
    F.tid = threadIdx.x; F.lane = F.tid & 63; F.wave = __builtin_amdgcn_readfirstlane(F.tid >> 6);
    F.G = gridDim.x; F.bx = blockIdx.x; { const int bx = blockIdx.x; F.vcu = (F.G % 8 == 0) ? (bx % 8) * (F.G / 8) + bx / 8 : bx; }
    volatile LAS unsigned* MISC = (volatile LAS unsigned*)(F.lds + MISC_OFF);
    if (F.tid < 16) MISC[F.tid] = 0u;
    __syncthreads();
    unsigned* ctl = (unsigned*)(F.ws + WS_CTL);
#if MK_MULTI
    XcdBarrier bar; bar.bar = ctl + CW_BAR; bar.x = 0; bar.st = MISC;
#define GRID_BAR() do { } while (0)
#else
    XcdBarrier bar = xcd_barrier_post(ctl + CW_BAR, MISC);
#define GRID_BAR() xcd_barrier(bar)
#endif
    const int lo = args.ph_lo, hi = args.ph_hi;
#define IN(k) (lo <= (k) && (k) < hi)
#define SEAM(k) do { if (IN(k) && IN((k) + 1)) GRID_BAR(); } while (0)

    if (PH_ON(0) && IN(0)) { p0_prologue(F, args); }
    SEAM(0);
#pragma nounroll
    for (int L = 0; L < DEPTH; ++L) {
        asm volatile("" : "+v"(F.tid), "+s"(F.wave), "+s"(F.vcu), "+s"(F.G), "+s"(F.bx), "+s"(F.ws), "+s"(F.out), "+s"(F.prm));
        F.lane = F.tid & 63;
        const int pb = 1 + 9 * L;
        bf16* xba = (bf16*)(F.ws + WS_XBA); bf16* xbb = (bf16*)(F.ws + WS_XBB);
        if (PH_ON(1) && IN(pb + 0)) {
            pg8::Order<1> S; S.init(NTOK, INW, DM, F.G, F.bx); S.A[0] = (const char*)xba; S.B[0] = (const char*)((bf16*)(F.ws + WS_WIN) + (size_t)L * INW * DM);
            pg8::EpiG1 E{(bf16*)(F.ws + WS_PNA), (bf16*)(F.ws + WS_PRT), (bf16*)(F.ws + WS_PGT), (const float*)(F.ws + WS_RSTD)};
            pg8::gemm_phase(F.lds, F.tid, DM, S, E);
        }
        SEAM(pb + 0);
        if (PH_ON(2) && IN(pb + 1)) { rot_phase(F); }
        SEAM(pb + 1);
        if (IN(pb + 2)) { if (PH_ON(3)) na_phase(F, L); __syncthreads(); if (PH_ON(4)) scan_phase(F, L); }
        SEAM(pb + 2);
        if (PH_ON(5) && IN(pb + 3)) { rout_phase(F, L); }
        SEAM(pb + 3);
        if (PH_ON(6) && IN(pb + 4)) {
            pg8::Order<2> S; S.init(NTOK, DM, 2048, F.G, F.bx);
            S.A[0] = (const char*)(F.ws + WS_AO); S.A[1] = (const char*)(F.ws + WS_BO);
            S.B[0] = (const char*)((bf16*)(F.ws + WS_WPA) + (size_t)L * DM * 2048); S.B[1] = (const char*)((bf16*)(F.ws + WS_WPB) + (size_t)L * DM * 2048);
            pg8::EpiG2 E{(const bf16*)(F.ws + WS_PGT), (bf16*)(F.ws + WS_T), (bf16*)(F.ws + WS_MRG)};
            pg8::gemm_phase(F.lds, F.tid, 2048, S, E);
        }
        SEAM(pb + 4);
        if (PH_ON(7) && IN(pb + 5)) {
#if PH_ON(10)
            { pg8::Order<1> S; S.init(NTOK, DM, DM, F.G, F.bx); S.A[0] = (const char*)(F.ws + WS_MRG); S.B[0] = (const char*)((bf16*)(F.ws + WS_WOUT) + (size_t)L * DM * DM);
              pg8::EpiStore<true> E{(bf16*)(F.ws + WS_Y), (float*)(F.ws + WS_PART)};
              pg8::gemm_phase(F.lds, F.tid, DM, S, E); }
#endif
#if PH_ON(11)
            { pg8::Order<1> S; S.init(NTOK, DM, PLE, F.G, F.bx); S.A[0] = (const char*)((bf16*)(F.ws + WS_PB) + (size_t)L * NTOK * PLE); S.B[0] = (const char*)((bf16*)(F.ws + WS_WPLE) + (size_t)L * DM * PLE);
              pg8::EpiStore<false> E{(bf16*)(F.ws + WS_E), nullptr};
              pg8::gemm_phase(F.lds, F.tid, PLE, S, E); }
#endif
        }
        SEAM(pb + 5);
        if (PH_ON(8) && IN(pb + 6)) { p6_phase(F, L); }
        SEAM(pb + 6);
        if (PH_ON(9) && IN(pb + 7)) {
            pg8::Order<1> S; S.init(NTOK, DM, DM, F.G, F.bx); S.A[0] = (const char*)xbb; S.B[0] = (const char*)((bf16*)(F.ws + WS_WG) + (size_t)L * DM * DM);
            pg8::EpiG4 E{F.out, (const bf16*)(F.ws + WS_E), xba, (float*)(F.ws + WS_PART2)};
            pg8::gemm_phase(F.lds, F.tid, DM, S, E);
        }
        SEAM(pb + 7);
        if (IN(pb + 8) && L + 1 < DEPTH) { rstd_phase(F); }
        if (L + 1 < DEPTH) SEAM(pb + 8);
    }
#undef IN
#undef SEAM
}

extern "C" void kernel_launch(void* const* d_in, const int* in_sizes, int n_in, void* d_out, int out_size, void* d_ws, size_t ws_size, hipStream_t stream) {
    static int grid = 0;
    if (grid == 0) {
        if (n_in != 16 || out_size != NTOK * DM || ws_size < WS_END) { fprintf(stderr, "kernel_launch: unexpected shapes (n_in %d, out %d, ws %zu < %zu); nothing launched\n", n_in, out_size, ws_size, (size_t)WS_END); grid = -1; return; }
        int dev = 0, cus = 0, per_cu = 0;
        if (hipGetDevice(&dev) != hipSuccess || hipDeviceGetAttribute(&cus, hipDeviceAttributeMultiprocessorCount, dev) != hipSuccess) { grid = -1; return; }
        if (hipFuncSetAttribute((const void*)fwd, hipFuncAttributeMaxDynamicSharedMemorySize, LDS_BYTES) != hipSuccess) { fprintf(stderr, "kernel_launch: hipFuncSetAttribute failed\n"); grid = -1; return; }
        if (hipOccupancyMaxActiveBlocksPerMultiprocessor(&per_cu, (const void*)fwd, 512, LDS_BYTES) != hipSuccess || per_cu < 1) fprintf(stderr, "kernel_launch: occupancy query says %d\n", per_cu);
        (void)hipGetLastError();
        grid = cus;
    }
    if (grid < 0) return;
    (void)hipMemsetAsync((char*)d_ws + WS_CTL, 0, CTL_ZERO_BYTES, stream);
    Args a{};
    for (int i = 0; i < 16; ++i) a.in[i] = (const float*)d_in[i];
    a.out = (float*)d_out; a.ws = (unsigned char*)d_ws;
#if MK_MULTI
    for (int p = 0; p < NPH; ++p) { a.ph_lo = p; a.ph_hi = p + 1; hipLaunchKernelGGL(fwd, dim3(grid), dim3(512), LDS_BYTES, stream, a); }
#else
    a.ph_lo = 0; a.ph_hi = NPH; hipLaunchKernelGGL(fwd, dim3(grid), dim3(512), LDS_BYTES, stream, a);
#endif
}
```

```cpp
#include <hip/hip_runtime.h>
#include <cstdio>
#include <cstdint>

#ifndef MK_MULTI
#define MK_MULTI 0
#endif
#ifndef PH_MASK
#define PH_MASK 0xFFFFF
#endif
#define PH_ON(b) ((PH_MASK >> (b)) & 1)

#define GAS __attribute__((address_space(1)))
#define LAS __attribute__((address_space(3)))
typedef unsigned short bf16;
typedef unsigned v4u __attribute__((ext_vector_type(4)));
typedef unsigned v2u __attribute__((ext_vector_type(2)));
typedef float f32x4 __attribute__((ext_vector_type(4)));
typedef float f32x2 __attribute__((ext_vector_type(2)));
typedef short bf16x8 __attribute__((ext_vector_type(8)));
typedef short s16x4 __attribute__((ext_vector_type(4)));

constexpr int DM = 4096, NTOK = 24576, NTOK_P = 16384, SEQ = 4096, NSEQ = 6, DEPTH = 2;
constexpr int INW = 22528, PLE = 256;
constexpr int LD_NA = 8192, LD_RT = 6144, LD_GT = 8192;
constexpr float EPS = 1e-6f;

constexpr size_t MiB = 1u << 20;
constexpr size_t WS_CTL = 0, CTL_ZERO_BYTES = 64 * 1024;
constexpr size_t WS_COS = 1 * MiB, WS_SIN = 2 * MiB, WS_RSTD = 3 * MiB, WS_PART = 4 * MiB, WS_PART2 = 10 * MiB;
constexpr size_t WS_WIN = 16 * MiB;
constexpr size_t WS_WPA = 368 * MiB, WS_WPB = 400 * MiB;
constexpr size_t WS_WOUT = 432 * MiB, WS_WG = 496 * MiB;
constexpr size_t WS_WPLE = 560 * MiB;
constexpr size_t WS_PB = 564 * MiB;
constexpr size_t WS_XBA = 588 * MiB, WS_XBB = 780 * MiB;
constexpr size_t WS_PNA = 972 * MiB;
constexpr size_t WS_PRT = 1356 * MiB;
constexpr size_t WS_PGT = 1644 * MiB;
constexpr size_t WS_AO = 2028 * MiB, WS_BO = 2124 * MiB;
constexpr size_t WS_MRG = 2220 * MiB, WS_Y = 2412 * MiB;
constexpr size_t WS_KVS = 2604 * MiB;
constexpr size_t WS_T = WS_PNA;
constexpr size_t WS_E = WS_PRT;
constexpr size_t WS_END = 2796 * MiB;
constexpr int CW_TMO = 0, CW_BAR = 1024;
constexpr size_t WS_PRM = 3 * MiB + 512 * 1024;
constexpr int PRM_RPB = 0, PRM_LDF = 14880, PRM_LDB = 14896, PRM_GN = 14912, PRM_LNPOST = 19008, PRM_N = 27200;

constexpr int LDS_BYTES = 155648;
constexpr int MISC_OFF = 153600;

__device__ __forceinline__ unsigned f2bf(float f) { unsigned u = __builtin_bit_cast(unsigned, f); return (u + 0x7fffu + ((u >> 16) & 1u)) >> 16; }
__device__ __forceinline__ unsigned pk2(float lo, float hi) { unsigned r; asm volatile("v_cvt_pk_bf16_f32 %0, %1, %2" : "=v"(r) : "v"(lo), "v"(hi)); return r; }
__device__ __forceinline__ float bflo(unsigned u) { return __builtin_bit_cast(float, u << 16); }
__device__ __forceinline__ float bfhi(unsigned u) { return __builtin_bit_cast(float, u & 0xffff0000u); }
__device__ __forceinline__ float sigmoidf_(float x) { return __builtin_amdgcn_rcpf(1.0f + __builtin_amdgcn_exp2f(-1.4426950408889634f * x)); }
__device__ __forceinline__ float expf_(float x) { return __builtin_amdgcn_exp2f(1.4426950408889634f * x); }
__device__ __forceinline__ float wave_sum(float v) {
#pragma unroll
    for (int o = 1; o < 64; o <<= 1) v += __shfl_xor(v, o);
    return v;
}
#define LDS_WAIT() asm volatile("s_waitcnt lgkmcnt(0)" ::: "memory")
#define VM_WAIT() asm volatile("s_waitcnt vmcnt(0)" ::: "memory")
__device__ __forceinline__ bf16x8 tr2(unsigned a0, unsigned a1) {
    s16x4 lo, hi;
    asm volatile("ds_read_b64_tr_b16 %0, %2\n\tds_read_b64_tr_b16 %1, %3\n\ts_waitcnt lgkmcnt(0)" : "=&v"(lo), "=&v"(hi) : "v"(a0), "v"(a1) : "memory");
    bf16x8 r; r[0] = lo[0]; r[1] = lo[1]; r[2] = lo[2]; r[3] = lo[3]; r[4] = hi[0]; r[5] = hi[1]; r[6] = hi[2]; r[7] = hi[3]; return r;
}
__device__ __forceinline__ void tr2x2(bf16x8& r0, bf16x8& r1, unsigned a0, unsigned a1, unsigned b0, unsigned b1) {
    s16x4 l0, h0, l1, h1;
    asm volatile("ds_read_b64_tr_b16 %0, %4\n\tds_read_b64_tr_b16 %1, %5\n\tds_read_b64_tr_b16 %2, %6\n\tds_read_b64_tr_b16 %3, %7\n\ts_waitcnt lgkmcnt(0)"
                 : "=&v"(l0), "=&v"(h0), "=&v"(l1), "=&v"(h1) : "v"(a0), "v"(a1), "v"(b0), "v"(b1) : "memory");
    r0[0] = l0[0]; r0[1] = l0[1]; r0[2] = l0[2]; r0[3] = l0[3]; r0[4] = h0[0]; r0[5] = h0[1]; r0[6] = h0[2]; r0[7] = h0[3];
    r1[0] = l1[0]; r1[1] = l1[1]; r1[2] = l1[2]; r1[3] = l1[3]; r1[4] = h1[0]; r1[5] = h1[1]; r1[6] = h1[2]; r1[7] = h1[3];
}
#define MFMA16(a, b, c) __builtin_amdgcn_mfma_f32_16x16x32_bf16((a), (b), (c), 0, 0, 0)

namespace pg8 {
#define PG8_LAS __attribute__((address_space(3)))
constexpr int BM = 256, BK = 64, HALF = 128, HTB = HALF * BK * 2, STAGE_BYTES = 8 * HTB, NXCD = 8, WGM = 8;
__host__ __device__ __forceinline__ int lds_byte(int r, int c) { const int st = (r >> 4) * 2 + (c >> 5), rr = r & 15, cc = c & 31, ob = rr * 64 + cc * 2; return st * 1024 + (ob ^ (((ob >> 9) & 1) << 5)); }
__host__ __device__ __forceinline__ void stage_rc(int b, int& R, int& C) { const int st = b / 1024, sb = b % 1024, swz = sb ^ (((sb >> 9) & 1) << 5); R = (st >> 1) * 16 + swz / 64; C = (st & 1) * 32 + (swz % 64) / 2; }
__host__ __device__ __forceinline__ int perm32(int rho) { const int n = rho >> 4, i = rho & 15; return 8 * (i >> 2) + 4 * n + (i & 3); }
struct Unit { int pm, pn, pass; };
template <int NP> struct Order {
    int nM, nN, nwg, G, c; const char* A[NP]; const char* B[NP]; size_t tstep;
    __device__ __forceinline__ void init(int M, int N, int K, int G_, int c_) { nM = M / BM; nN = N / BM; nwg = nM * nN; G = G_; c = c_; tstep = (size_t)BM * K * 2; }
    __device__ __forceinline__ bool next(int i, Unit& u) const {
        const int tile = i / NP; u.pass = i - tile * NP;
        const long L = (long)tile * G + c; if (L >= nwg) return false;
        int wgid = (int)L; { const int q = nwg / NXCD, r = nwg % NXCD, xcd = wgid % NXCD, off = wgid / NXCD; wgid = (xcd < r ? xcd * (q + 1) : r * (q + 1) + (xcd - r) * q) + off; }
        const int nig = WGM * nN, gid = wgid / nig, fm = gid * WGM, gsz = (nM - fm) < WGM ? (nM - fm) : WGM;
        u.pm = fm + ((wgid % nig) % gsz); u.pn = (wgid % nig) / gsz; return true;
    }
    __device__ __forceinline__ const char* aptr(const Unit& u) const { return ((NP == 1 || u.pass == 0) ? A[0] : A[NP - 1]) + (size_t)u.pm * tstep; }
    __device__ __forceinline__ const char* bptr(const Unit& u) const { return ((NP == 1 || u.pass == 0) ? B[0] : B[NP - 1]) + (size_t)u.pn * tstep; }
};

template <class Epi, class Sched>
__device__ __forceinline__ void gemm_phase(PG8_LAS unsigned char* lds, const int tid, const int K, const Sched& S, const Epi& E) {
    const int wid = __builtin_amdgcn_readfirstlane(tid >> 6), lane = tid & 63, wr = wid >> 2, wc = wid & 3, fr = lane & 15, fq = lane >> 4;
    const int nt = K / BK;
    unsigned voffA[2], voffB[2];
#pragma unroll
    for (int i = 0; i < 2; ++i) { int R, C; stage_rc(tid * 16 + i * 8192, R, C); const int Rb = (R & ~31) + perm32(R & 31);
        voffA[i] = (unsigned)(R * K + C) * 2u; voffB[i] = (unsigned)(Rb * K + C) * 2u; }
    const size_t kstep = (size_t)(BK * 2);
    const size_t hstep = (size_t)HALF * K * 2;
    const unsigned ldsw = (unsigned)wid * 1024u;
    const int aoff = lds_byte(wr * 64 + fr, fq * 8), boff = lds_byte(wc * 32 + fr, fq * 8);
#define PG8_SA(b, h) (((b) * 2 + (h)) * HTB)
#define PG8_SB(b, h) ((4 + (b) * 2 + (h)) * HTB)
#define PG8_STAGE(bufoff, gbase, voff) do { _Pragma("unroll") for (int _i = 0; _i < 2; ++_i) \
        __builtin_amdgcn_global_load_lds((const unsigned*)((const char*)(gbase) + (voff)[_i]), (PG8_LAS unsigned*)(lds + (bufoff) + ldsw + _i * 8192), 16, 0, 0); } while (0)
#define PG8_LDA(dst, b, h) do { _Pragma("unroll") for (int m = 0; m < 4; ++m) _Pragma("unroll") for (int k = 0; k < 2; ++k) dst[m][k] = *(const PG8_LAS bf16x8*)(lds + PG8_SA(b, h) + aoff + m * 2048 + k * 1024); } while (0)
#define PG8_LDB(dst, b, h) do { _Pragma("unroll") for (int n = 0; n < 2; ++n) _Pragma("unroll") for (int k = 0; k < 2; ++k) dst[n][k] = *(const PG8_LAS bf16x8*)(lds + PG8_SB(b, h) + boff + n * 2048 + k * 1024); } while (0)
#define PG8_MMA(ai, bj, At, Bt) do { __builtin_amdgcn_s_setprio(1); _Pragma("unroll") for (int m = 0; m < 4; ++m) _Pragma("unroll") for (int n = 0; n < 2; ++n) _Pragma("unroll") for (int k = 0; k < 2; ++k) \
        acc[ai][bj][m][n] = __builtin_amdgcn_mfma_f32_16x16x32_bf16(Bt[n][k], At[m][k], acc[ai][bj][m][n], 0, 0, 0); __builtin_amdgcn_s_setprio(0); } while (0)
#define PG8_WAIT_V(n) asm volatile("s_waitcnt vmcnt(" #n ")" ::: "memory")
#define PG8_WAIT_L(n) asm volatile("s_waitcnt lgkmcnt(" #n ")" ::: "memory")
#define PG8_BAR __builtin_amdgcn_s_barrier()
#define PG8_SCHED __builtin_amdgcn_sched_barrier(0)
    Unit cur, nxt; int ui = 0;
    if (!S.next(0, cur)) return;
    f32x4 acc[2][2][4][2];
#pragma unroll
    for (int a = 0; a < 2; ++a)
#pragma unroll
        for (int b = 0; b < 2; ++b)
#pragma unroll
            for (int m = 0; m < 4; ++m)
#pragma unroll
                for (int n = 0; n < 2; ++n) acc[a][b][m][n] = (f32x4){0.f, 0.f, 0.f, 0.f};
    bf16x8 At[4][2], B0[2][2], B1[2][2];
    const char* cA = S.aptr(cur); const char* cB = S.bptr(cur);
    PG8_STAGE(PG8_SB(0, 0), cB, voffB); PG8_STAGE(PG8_SB(0, 1), cB + hstep, voffB); PG8_STAGE(PG8_SA(0, 0), cA, voffA); PG8_STAGE(PG8_SA(0, 1), cA + hstep, voffA);
    if (wr == 1) PG8_BAR;
    PG8_WAIT_V(2); PG8_BAR;
    PG8_STAGE(PG8_SB(1, 0), cB + kstep, voffB); PG8_STAGE(PG8_SA(1, 0), cA + kstep, voffA); PG8_STAGE(PG8_SB(1, 1), cB + hstep + kstep, voffB);
    PG8_WAIT_V(6); PG8_BAR;
    for (;;) {
        const bool has_next = S.next(ui + 1, nxt);
        const char* nA = has_next ? S.aptr(nxt) : cA; const char* nB = has_next ? S.bptr(nxt) : cB;
#pragma nounroll
        for (int t = 0; t < nt; t += 2) {
            const bool last = (t == nt - 2);
            const char* a1 = cA + (size_t)(t + 1) * kstep;
            const char* a2 = last ? nA : cA + (size_t)(t + 2) * kstep; const char* b2 = last ? nB : cB + (size_t)(t + 2) * kstep;
            const char* a3 = a2 + kstep; const char* b3 = b2 + kstep;
            PG8_LDB(B0, 0, 0); PG8_LDB(B1, 0, 1); PG8_SCHED; PG8_LDA(At, 0, 0); PG8_STAGE(PG8_SA(1, 1), a1 + hstep, voffA);
            PG8_WAIT_V(8); PG8_WAIT_L(0); PG8_BAR; PG8_MMA(0, 0, At, B0); PG8_MMA(0, 1, At, B1); PG8_BAR; PG8_SCHED;
            PG8_LDA(At, 0, 1); PG8_STAGE(PG8_SB(0, 0), b2, voffB); PG8_STAGE(PG8_SB(0, 1), b2 + hstep, voffB); PG8_STAGE(PG8_SA(0, 0), a2, voffA);
            PG8_WAIT_V(8); PG8_WAIT_L(0); PG8_BAR; PG8_MMA(1, 0, At, B0); PG8_MMA(1, 1, At, B1); PG8_BAR; PG8_SCHED;
            PG8_LDB(B0, 1, 0); PG8_LDB(B1, 1, 1); PG8_SCHED; PG8_LDA(At, 1, 0); PG8_STAGE(PG8_SA(0, 1), a2 + hstep, voffA);
            PG8_WAIT_V(8); PG8_WAIT_L(0); PG8_BAR; PG8_MMA(0, 0, At, B0); PG8_MMA(0, 1, At, B1); PG8_BAR; PG8_SCHED;
            PG8_LDA(At, 1, 1); PG8_STAGE(PG8_SB(1, 0), b3, voffB); PG8_STAGE(PG8_SB(1, 1), b3 + hstep, voffB); PG8_STAGE(PG8_SA(1, 0), a3, voffA);
            PG8_WAIT_V(8); PG8_WAIT_L(0); PG8_BAR; PG8_MMA(1, 0, At, B0); PG8_MMA(1, 1, At, B1); PG8_BAR; PG8_SCHED;
        }
        if (wr == 0) PG8_BAR;
        E(acc, cur, wr, wc, fr, fq);
        if (!has_next) break;
#pragma unroll
        for (int a = 0; a < 2; ++a)
#pragma unroll
            for (int b = 0; b < 2; ++b)
#pragma unroll
                for (int m = 0; m < 4; ++m)
#pragma unroll
                    for (int n = 0; n < 2; ++n) acc[a][b][m][n] = (f32x4){0.f, 0.f, 0.f, 0.f};
        cur = nxt; cA = nA; cB = nB; ++ui;
        if (wr == 1) PG8_BAR;
    }
    PG8_WAIT_V(0);
    PG8_BAR;
#undef PG8_SA
#undef PG8_SB
#undef PG8_STAGE
#undef PG8_LDA
#undef PG8_LDB
#undef PG8_MMA
#undef PG8_WAIT_V
#undef PG8_WAIT_L
#undef PG8_BAR
#undef PG8_SCHED
}

typedef float f32x4_ __attribute__((ext_vector_type(4)));
struct EpiG1 {
    bf16 *pna, *prt, *pgt; const float* rstd;
    __device__ __forceinline__ void operator()(const f32x4 (&acc)[2][2][4][2], const Unit& u, int wr, int wc, int fr, int fq) const {
        bf16* base; int ld, colt, act;
        if (u.pn < 32) { base = pna; ld = LD_NA; colt = u.pn * BM; act = (u.pn >= 24) ? 1 : 0; }
        else if (u.pn < 56) { base = prt; ld = LD_RT; colt = (u.pn - 32) * BM; act = (u.pn >= 48) ? 1 : 0; }
        else { base = pgt; ld = LD_GT; colt = (u.pn - 56) * BM; act = 2; }
        const int row0 = u.pm * BM + wr * 64 + fr, col0 = colt + wc * 32 + 8 * fq;
        float rsv[2][4];
#pragma unroll
        for (int ai = 0; ai < 2; ++ai)
#pragma unroll
            for (int m = 0; m < 4; ++m) rsv[ai][m] = rstd[row0 + ai * HALF + m * 16];
#pragma unroll
        for (int ai = 0; ai < 2; ++ai)
#pragma unroll
            for (int m = 0; m < 4; ++m) { const int row = row0 + ai * HALF + m * 16; const float rs = rsv[ai][m]; bf16* rowp = base + (size_t)row * ld + col0;
#pragma unroll
                for (int bj = 0; bj < 2; ++bj) { f32x4 v0 = acc[ai][bj][m][0] * rs, v1 = acc[ai][bj][m][1] * rs;
                    if (act != 0) {
#pragma unroll
                        for (int j = 0; j < 4; ++j) { const float s0 = sigmoidf_(v0[j]), s1 = sigmoidf_(v1[j]); v0[j] = (act == 1) ? v0[j] * s0 : s0; v1[j] = (act == 1) ? v1[j] * s1 : s1; } }
                    v4u w; w.x = pk2(v0[0], v0[1]); w.y = pk2(v0[2], v0[3]); w.z = pk2(v1[0], v1[1]); w.w = pk2(v1[2], v1[3]);
                    *(v4u*)(rowp + bj * HALF) = w; } }
    }
};
struct EpiG2 {
    const bf16* pgt; bf16* T; bf16* mrg;
    __device__ __forceinline__ void operator()(const f32x4 (&acc)[2][2][4][2], const Unit& u, int wr, int wc, int fr, int fq) const {
        const int row0 = u.pm * BM + wr * 64 + fr, col0 = u.pn * BM + wc * 32 + 8 * fq;
#pragma unroll
        for (int ai = 0; ai < 2; ++ai)
#pragma unroll
            for (int m = 0; m < 4; ++m) { const int row = row0 + ai * HALF + m * 16;
#pragma unroll
                for (int bj = 0; bj < 2; ++bj) { const int col = col0 + bj * HALF;
                    const v4u gt = *(const v4u*)(pgt + (size_t)row * LD_GT + u.pass * DM + col);
                    f32x4 v0 = acc[ai][bj][m][0], v1 = acc[ai][bj][m][1];
                    v0[0] *= bflo(gt.x); v0[1] *= bfhi(gt.x); v0[2] *= bflo(gt.y); v0[3] *= bfhi(gt.y); v1[0] *= bflo(gt.z); v1[1] *= bfhi(gt.z); v1[2] *= bflo(gt.w); v1[3] *= bfhi(gt.w);
                    bf16* dst = T + (size_t)row * DM + col;
                    if (u.pass == 1) { const v4u t = *(const v4u*)dst;
                        v0[0] += bflo(t.x); v0[1] += bfhi(t.x); v0[2] += bflo(t.y); v0[3] += bfhi(t.y); v1[0] += bflo(t.z); v1[1] += bfhi(t.z); v1[2] += bflo(t.w); v1[3] += bfhi(t.w);
                        dst = mrg + (size_t)row * DM + col; }
                    v4u w; w.x = pk2(v0[0], v0[1]); w.y = pk2(v0[2], v0[3]); w.z = pk2(v1[0], v1[1]); w.w = pk2(v1[2], v1[3]);
                    *(v4u*)dst = w; }
                asm volatile("" ::: "memory"); }
    }
};
template <bool STATS> struct EpiStore {
    bf16* O; float* part;
    __device__ __forceinline__ void operator()(const f32x4 (&acc)[2][2][4][2], const Unit& u, int wr, int wc, int fr, int fq) const {
        const int row0 = u.pm * BM + wr * 64 + fr, col0 = u.pn * BM + wc * 32 + 8 * fq;
#pragma unroll
        for (int ai = 0; ai < 2; ++ai)
#pragma unroll
            for (int m = 0; m < 4; ++m) { const int row = row0 + ai * HALF + m * 16; float ss = 0.f;
#pragma unroll
                for (int bj = 0; bj < 2; ++bj) { const f32x4 v0 = acc[ai][bj][m][0], v1 = acc[ai][bj][m][1];
                    if (STATS) ss += (v0[0] * v0[0] + v0[1] * v0[1]) + (v0[2] * v0[2] + v0[3] * v0[3]) + (v1[0] * v1[0] + v1[1] * v1[1]) + (v1[2] * v1[2] + v1[3] * v1[3]);
                    v4u w; w.x = pk2(v0[0], v0[1]); w.y = pk2(v0[2], v0[3]); w.z = pk2(v1[0], v1[1]); w.w = pk2(v1[2], v1[3]);
                    *(v4u*)(O + (size_t)row * DM + col0 + bj * HALF) = w; }
                if (STATS) { ss += __shfl_xor(ss, 16); ss += __shfl_xor(ss, 32); if (fq == 0) part[(size_t)row * 64 + u.pn * 4 + wc] = ss; } }
    }
};
struct EpiG4 {
    float* xio; const bf16* E; bf16* xb; float* part;
    __device__ __forceinline__ void operator()(const f32x4 (&acc)[2][2][4][2], const Unit& u, int wr, int wc, int fr, int fq) const {
        const int row0 = u.pm * BM + wr * 64 + fr, col0 = u.pn * BM + wc * 32 + 8 * fq;
#pragma unroll
        for (int ai = 0; ai < 2; ++ai)
#pragma unroll
            for (int m = 0; m < 4; ++m) { const int row = row0 + ai * HALF + m * 16; float ss = 0.f;
#pragma unroll
                for (int bj = 0; bj < 2; ++bj) { const size_t off = (size_t)row * DM + col0 + bj * HALF;
                    const v4u e = *(const v4u*)(E + off); const f32x4 x0 = *(const f32x4*)(xio + off), x1 = *(const f32x4*)(xio + off + 4);
                    const f32x4 a0 = acc[ai][bj][m][0], a1 = acc[ai][bj][m][1]; f32x4 v0, v1;
                    v0[0] = x0[0] + sigmoidf_(a0[0]) * bflo(e.x); v0[1] = x0[1] + sigmoidf_(a0[1]) * bfhi(e.x); v0[2] = x0[2] + sigmoidf_(a0[2]) * bflo(e.y); v0[3] = x0[3] + sigmoidf_(a0[3]) * bfhi(e.y);
                    v1[0] = x1[0] + sigmoidf_(a1[0]) * bflo(e.z); v1[1] = x1[1] + sigmoidf_(a1[1]) * bfhi(e.z); v1[2] = x1[2] + sigmoidf_(a1[2]) * bflo(e.w); v1[3] = x1[3] + sigmoidf_(a1[3]) * bfhi(e.w);
                    ss += (v0[0] * v0[0] + v0[1] * v0[1]) + (v0[2] * v0[2] + v0[3] * v0[3]) + (v1[0] * v1[0] + v1[1] * v1[1]) + (v1[2] * v1[2] + v1[3] * v1[3]);
                    *(f32x4*)(xio + off) = v0; *(f32x4*)(xio + off + 4) = v1;
                    v4u w; w.x = pk2(v0[0], v0[1]); w.y = pk2(v0[2], v0[3]); w.z = pk2(v1[0], v1[1]); w.w = pk2(v1[2], v1[3]);
                    *(v4u*)(xb + off) = w; }
                ss += __shfl_xor(ss, 16); ss += __shfl_xor(ss, 32); if (fq == 0) part[(size_t)row * 64 + u.pn * 4 + wc] = ss;
                asm volatile("" ::: "memory"); }
    }
};
}

#define XB_TMO      128
#define XB_XCNT(j)  (256  + 64 * (j))
#define XB_XSUB(j)  (1280 + 64 * (j))
#define XB_XGEN(j)  (2304 + 64 * (j))
#define XB_TOP      3328
#define XB_TOPGEN   3392
#define XCD_BAR_WORDS 3456
#define XB_SPIN_CAP (1u << 22)
__device__ __forceinline__ unsigned xb_ld(unsigned* p)              { return __hip_atomic_load(p, __ATOMIC_RELAXED, __HIP_MEMORY_SCOPE_AGENT); }
__device__ __forceinline__ unsigned xb_add(unsigned* p, unsigned v) { return __hip_atomic_fetch_add(p, v, __ATOMIC_RELAXED, __HIP_MEMORY_SCOPE_AGENT); }
__device__ __forceinline__ unsigned xb_xcc_id() { return (unsigned)__builtin_amdgcn_s_getreg((3 << 11) | 20) & 0xFu; }
#define XB_SPIN(cond, bar) do { unsigned _sp = 0; while (cond) { __builtin_amdgcn_s_sleep(1); \
    if ((++_sp & 255u) == 0u) { if (xb_ld(&(bar)[XB_TMO])) break; if (_sp > XB_SPIN_CAP) { atomicAdd(&(bar)[XB_TMO], 1u); break; } } } } while (0)
struct XcdBarrier { unsigned* bar; unsigned x; volatile LAS unsigned* st; };
__device__ __forceinline__ XcdBarrier xcd_barrier_post(unsigned* bar, volatile LAS unsigned* st) {
    XcdBarrier b; b.bar = bar; b.x = xb_xcc_id(); b.st = st;
    if (threadIdx.x == 0) (void)xb_add(&bar[XB_XCNT(b.x)], 1u);
    return b;
}
__device__ __forceinline__ void xcd_barrier_complete(unsigned* bar, unsigned x, unsigned& nloc, unsigned& nx) {
    const unsigned G = gridDim.x * gridDim.y * gridDim.z;
    unsigned sum, cnt, mine, sp = 0u;
    for (;;) {
        sum = 0u; cnt = 0u; mine = 0u;
#pragma unroll
        for (unsigned j = 0; j < 16; ++j) { const unsigned c = xb_ld(&bar[XB_XCNT(j)]); sum += c; cnt += (c > 0u) ? 1u : 0u; mine = (j == x) ? c : mine; }
        if (sum == G) break;
        __builtin_amdgcn_s_sleep(1);
        if ((++sp & 255u) == 0u) { if (xb_ld(&bar[XB_TMO])) break; if (sp > XB_SPIN_CAP) { atomicAdd(&bar[XB_TMO], 1u); break; } }
    }
    nloc = mine > 0u ? mine : 1u; nx = cnt > 0u ? cnt : 1u;
}
__device__ __forceinline__ void xcd_barrier(const XcdBarrier& b) {
    asm volatile("s_waitcnt vmcnt(0)" ::: "memory");
    __syncthreads();
    if (threadIdx.x == 0) {
        unsigned* bar = b.bar;
        __builtin_amdgcn_s_waitcnt(0);
        unsigned nloc = b.st[0], nx = b.st[1];
        if (nloc == 0u) { xcd_barrier_complete(bar, b.x, nloc, nx); b.st[0] = nloc; b.st[1] = nx; }
        const unsigned old = xb_add(&bar[XB_XSUB(b.x)], 1u);
        const unsigned gen = old / nloc;
        if (old + 1u == (gen + 1u) * nloc) {
            __builtin_amdgcn_fence(__ATOMIC_RELEASE, "agent");
            asm volatile("s_waitcnt vmcnt(0)" ::: "memory");
            const unsigned og = xb_add(&bar[XB_TOP], 1u);
            const unsigned tg = og / nx;
            if (og + 1u == (tg + 1u) * nx) xb_add(&bar[XB_TOPGEN], 1u);
            else XB_SPIN(xb_ld(&bar[XB_TOPGEN]) == tg, bar);
            __builtin_amdgcn_fence(__ATOMIC_ACQUIRE, "agent");
            xb_add(&bar[XB_XGEN(b.x)], 1u);
            asm volatile("s_waitcnt vmcnt(0)" ::: "memory");
        } else {
            XB_SPIN(xb_ld(&bar[XB_XGEN(b.x)]) == gen, bar);
            __builtin_amdgcn_fence(__ATOMIC_ACQUIRE, "agent");
            asm volatile("s_waitcnt vmcnt(0)" ::: "memory");
        }
    }
    __syncthreads();
}

struct Args { const float* in[16]; float* out; unsigned char* ws; int ph_lo, ph_hi; };
struct Frame {
    LAS unsigned char* lds; unsigned char* ws; const float* xp; const float* xs; const float* prm; float* out;
    int tid, lane, wave, vcu, G, bx;
};
enum { I_XP = 0, I_XS, I_PP, I_PS, I_WIN, I_LNPRE, I_LNPOST, I_RPB, I_LDF, I_LDB, I_GN, I_WPA, I_WPB, I_WOUT, I_WPLE, I_WG };

__device__ __forceinline__ void p0_transpose_item(const float* W, int K, int N, bf16* WT, const float* scale, LAS float* scr, int item, int lane) {
    const int nblk = N / 32, kb = item / nblk, nb = item % nblk, k0 = 64 * kb, n0 = 32 * nb;
#pragma unroll 8
    for (int i = 0; i < 32; ++i) { const int kk = 2 * i + (lane >> 5); float v = W[(size_t)(k0 + kk) * N + n0 + (lane & 31)]; if (scale) v *= scale[k0 + kk]; scr[kk * 33 + (lane & 31)] = v; }
    LDS_WAIT(); asm volatile("" ::: "memory");
    const int c = lane & 7;
#pragma unroll
    for (int j = 0; j < 4; ++j) { const int n = (lane >> 3) + 8 * j; const LAS float* s = scr + (8 * c) * 33 + n;
        v4u o; o.x = pk2(s[0 * 33], s[1 * 33]); o.y = pk2(s[2 * 33], s[3 * 33]); o.z = pk2(s[4 * 33], s[5 * 33]); o.w = pk2(s[6 * 33], s[7 * 33]);
        *(v4u*)(WT + (size_t)(n0 + n) * K + k0 + 8 * c) = o; }
    LDS_WAIT(); asm volatile("" ::: "memory");
}
__device__ __forceinline__ void p0_prologue(Frame& F, const Args& A) {
    LAS float* scr = (LAS float*)(F.lds + F.wave * 16384);
    const int gw = F.vcu * 8 + F.wave, NGW = F.G * 8;
    constexpr int I_IN = (DM / 64) * (INW / 32), I_PA = (2048 / 64) * (DM / 32), I_O = (DM / 64) * (DM / 32), I_PL = (PLE / 64) * (DM / 32);
    constexpr int PER_L = I_IN + 2 * I_PA + 2 * I_O + I_PL;
    for (int it = gw; it < 2 * PER_L; it += NGW) {
        const int L = it / PER_L; int r = it - L * PER_L;
        if (r < I_IN) { p0_transpose_item(A.in[I_WIN] + (size_t)L * DM * INW, DM, INW, (bf16*)(F.ws + WS_WIN) + (size_t)L * INW * DM, A.in[I_LNPRE] + L * DM, scr, r, F.lane); continue; } r -= I_IN;
        if (r < I_PA) { p0_transpose_item(A.in[I_WPA] + (size_t)L * 2048 * DM, 2048, DM, (bf16*)(F.ws + WS_WPA) + (size_t)L * DM * 2048, nullptr, scr, r, F.lane); continue; } r -= I_PA;
        if (r < I_PA) { p0_transpose_item(A.in[I_WPB] + (size_t)L * 2048 * DM, 2048, DM, (bf16*)(F.ws + WS_WPB) + (size_t)L * DM * 2048, nullptr, scr, r, F.lane); continue; } r -= I_PA;
        if (r < I_O) { p0_transpose_item(A.in[I_WOUT] + (size_t)L * DM * DM, DM, DM, (bf16*)(F.ws + WS_WOUT) + (size_t)L * DM * DM, nullptr, scr, r, F.lane); continue; } r -= I_O;
        if (r < I_O) { p0_transpose_item(A.in[I_WG] + (size_t)L * DM * DM, DM, DM, (bf16*)(F.ws + WS_WG) + (size_t)L * DM * DM, nullptr, scr, r, F.lane); continue; } r -= I_O;
        p0_transpose_item(A.in[I_WPLE] + (size_t)L * PLE * DM, PLE, DM, (bf16*)(F.ws + WS_WPLE) + (size_t)L * DM * PLE, nullptr, scr, r, F.lane);
    }
    float* rstd = (float*)(F.ws + WS_RSTD); bf16* xb = (bf16*)(F.ws + WS_XBA);
    for (int m = gw; m < NTOK; m += NGW) {
        const float* xr = (m < NTOK_P) ? A.in[I_XP] + (size_t)m * DM : A.in[I_XS] + (size_t)(m - NTOK_P) * DM;
        float s = 0.f;
#pragma unroll 4
        for (int j = 0; j < 16; ++j) { const f32x4 v = *(const f32x4*)(xr + j * 256 + F.lane * 4); s += (v[0] * v[0] + v[1] * v[1]) + (v[2] * v[2] + v[3] * v[3]);
            v2u w; w.x = pk2(v[0], v[1]); w.y = pk2(v[2], v[3]); *(v2u*)(xb + (size_t)m * DM + j * 256 + F.lane * 4) = w; }
        s = wave_sum(s);
        if (F.lane == 0) rstd[m] = 1.0f / sqrtf(s * (1.0f / DM) + EPS);
    }
    bf16* pb = (bf16*)(F.ws + WS_PB);
    for (int i = gw * 64 + F.lane; i < 2 * NTOK * (PLE / 4); i += NGW * 64) {
        const int L = i / (NTOK * (PLE / 4)), r = i - L * (NTOK * (PLE / 4)), m = r / (PLE / 4), c4 = r % (PLE / 4);
        const float* src = (m < NTOK_P) ? A.in[I_PP] + ((size_t)L * NTOK_P + m) * PLE : A.in[I_PS] + ((size_t)L * (NTOK - NTOK_P) + (m - NTOK_P)) * PLE;
        const f32x4 v = *(const f32x4*)(src + c4 * 4); v2u w; w.x = pk2(v[0], v[1]); w.y = pk2(v[2], v[3]);
        *(v2u*)(pb + ((size_t)L * NTOK + m) * PLE + c4 * 4) = w;
    }
    { float* prm = (float*)(F.ws + WS_PRM);
      for (int i = gw * 64 + F.lane; i < PRM_N; i += NGW * 64) {
          float v;
          if (i < PRM_LDF) v = A.in[I_RPB][i]; else if (i < PRM_LDB) v = A.in[I_LDF][i - PRM_LDF]; else if (i < PRM_GN) v = A.in[I_LDB][i - PRM_LDB];
          else if (i < PRM_LNPOST) v = A.in[I_GN][i - PRM_GN]; else v = A.in[I_LNPOST][i - PRM_LNPOST];
          prm[i] = v; } }
    float* ct = (float*)(F.ws + WS_COS); float* st = (float*)(F.ws + WS_SIN);
    for (int i = gw * 64 + F.lane; i < SEQ * 64; i += NGW * 64) {
        const int pos = i >> 6, k = i & 63;
        const float inv = __builtin_amdgcn_exp2f(-(float)k * 0.20762050593046014f);
        const float ang = (float)pos * inv;
        const float n = rintf(ang * 0.15915494f);
        const float fr_ = __builtin_fmaf(ang, 0.15915494f, -n) + ang * 6.4206e-9f;
        ct[i] = __builtin_amdgcn_cosf(fr_); st[i] = __builtin_amdgcn_sinf(fr_);
    }
}

__device__ __forceinline__ void rot_phase(Frame& F) {
    bf16* prt = (bf16*)(F.ws + WS_PRT); const float* ct = (const float*)(F.ws + WS_COS); const float* st = (const float*)(F.ws + WS_SIN);
    const int gt = (F.vcu * 8 + F.wave) * 64 + F.lane, NT = F.G * 512;
    for (int i = gt; i < NTOK * 128; i += NT) {
        const int m = i >> 7, r = i & 127, which = r >> 6, h = (r >> 3) & 7, c = r & 7, pos = m & (SEQ - 1);
        bf16* p = prt + (size_t)m * LD_RT + which * 1024 + h * 128 + c * 8;
        const v4u lo = *(const v4u*)p, hi = *(const v4u*)(p + 64);
        const f32x4 c0 = *(const f32x4*)(ct + pos * 64 + c * 8), c1 = *(const f32x4*)(ct + pos * 64 + c * 8 + 4);
        const f32x4 s0 = *(const f32x4*)(st + pos * 64 + c * 8), s1 = *(const f32x4*)(st + pos * 64 + c * 8 + 4);
        const float sc = which ? 0.08838834764831845f : 1.0f;
        float a[8] = {bflo(lo.x), bfhi(lo.x), bflo(lo.y), bfhi(lo.y), bflo(lo.z), bfhi(lo.z), bflo(lo.w), bfhi(lo.w)};
        float b[8] = {bflo(hi.x), bfhi(hi.x), bflo(hi.y), bfhi(hi.y), bflo(hi.z), bfhi(hi.z), bflo(hi.w), bfhi(hi.w)};
        const float cs[8] = {c0[0], c0[1], c0[2], c0[3], c1[0], c1[1], c1[2], c1[3]}, sn[8] = {s0[0], s0[1], s0[2], s0[3], s1[0], s1[1], s1[2], s1[3]};
        float ol[8], oh[8];
#pragma unroll
        for (int j = 0; j < 8; ++j) { ol[j] = (a[j] * cs[j] - b[j] * sn[j]) * sc; oh[j] = (a[j] * sn[j] + b[j] * cs[j]) * sc; }
        v4u wl, wh; wl.x = pk2(ol[0], ol[1]); wl.y = pk2(ol[2], ol[3]); wl.z = pk2(ol[4], ol[5]); wl.w = pk2(ol[6], ol[7]);
        wh.x = pk2(oh[0], oh[1]); wh.y = pk2(oh[2], oh[3]); wh.z = pk2(oh[4], oh[5]); wh.w = pk2(oh[6], oh[7]);
        *(v4u*)p = wl; *(v4u*)(p + 64) = wh;
    }
}

constexpr int NA_VSTRIDE = 288;
constexpr int NA_BIAS_OFF = 0, NA_V_OFF = 4096, NA_VROW = 64 * NA_VSTRIDE;
__device__ __forceinline__ void na_phase(Frame& F, int L) {
    const bf16* pna = (const bf16*)(F.ws + WS_PNA); bf16* ao = (bf16*)(F.ws + WS_AO);
    const float* rpb = F.prm + PRM_RPB + (size_t)L * 16 * 465;
    const int lane = F.lane, fr0 = lane & 15, g0 = lane >> 4, usub = F.wave >> 2, qblk = F.wave & 3;
    LAS float* lb = (LAS float*)(F.lds + NA_BIAS_OFF);
    const unsigned vlds = (unsigned)(size_t)(F.lds + NA_V_OFF);
    const float scale = 0.08838834764831845f;
    for (int up = F.vcu; up < NSEQ * 64 * 8; up += F.G) {
        int fr = fr0, g = g0; asm volatile("" : "+v"(fr), "+v"(g));
        const int b = up >> 9, hp = (up >> 6) & 7, r = up & 63, h = 2 * hp + usub;
        const int rs = min(max(r - 4, 0), 56);
        const int tokq = b * SEQ + r * 64 + 16 * qblk + fr;
        for (int i = F.tid; i < 2 * 465; i += 512) lb[(i >= 465 ? 512 : 0) + (i >= 465 ? i - 465 : i)] = rpb[(size_t)(2 * hp) * 465 + i];
        bf16x8 Qf[4];
#pragma unroll
        for (int ks = 0; ks < 4; ++ks) Qf[ks] = *(const bf16x8*)(pna + (size_t)tokq * LD_NA + h * 128 + 32 * ks + 8 * g);
        const int kc0 = min(max(16 * qblk - 8, 0), 32);
        f32x4 S[16];
#pragma unroll
        for (int kb = 0; kb < 16; ++kb) {
            const int wr = kb >> 1, cb = kb & 1;
            const bf16* kp = pna + (size_t)(b * SEQ + (rs + wr) * 64 + kc0 + 16 * cb + fr) * LD_NA + 2048 + h * 128 + 8 * g;
            bf16x8 Kf[4];
#pragma unroll
            for (int ks = 0; ks < 4; ++ks) Kf[ks] = *(const bf16x8*)(kp + 32 * ks);
            f32x4 a = (f32x4){0.f, 0.f, 0.f, 0.f};
#pragma unroll
            for (int ks = 0; ks < 4; ++ks) a = MFMA16(Kf[ks], Qf[ks], a);
            S[kb] = a;
        }
        __syncthreads();
        const int c = 16 * qblk + fr, cs = min(max(c - 8, 0), 48);
        const LAS float* lbh = lb + usub * 512;
        float mx = -3.0e38f;
#pragma unroll
        for (int kb = 0; kb < 16; ++kb) {
            const int wr = kb >> 1, cb = kb & 1;
#pragma unroll
            for (int e = 0; e < 4; ++e) {
                const int kc = kc0 + 16 * cb + 4 * g + e; const bool valid = (kc >= cs) && (kc < cs + 16);
                const int bi = (rs + wr - r + 7) * 31 + (kc - c + 15);
                const float bias = valid ? lbh[bi] : 0.f;
                const float s = valid ? S[kb][e] * scale + bias : -3.0e38f;
                S[kb][e] = s; mx = fmaxf(mx, s);
            }
        }
        mx = fmaxf(mx, __shfl_xor(mx, 16)); mx = fmaxf(mx, __shfl_xor(mx, 32));
        float sum = 0.f;
#pragma unroll
        for (int kb = 0; kb < 16; ++kb)
#pragma unroll
            for (int e = 0; e < 4; ++e) { const float p = (S[kb][e] > -1.0e38f) ? expf_(S[kb][e] - mx) : 0.f; S[kb][e] = p; sum += p; }
        sum += __shfl_xor(sum, 16); sum += __shfl_xor(sum, 32);
        const float inv = 1.0f / sum;
        bf16x8 Pf[8];
#pragma unroll
        for (int wr = 0; wr < 8; ++wr) { v4u w; w.x = pk2(S[2 * wr][0], S[2 * wr][1]); w.y = pk2(S[2 * wr][2], S[2 * wr][3]); w.z = pk2(S[2 * wr + 1][0], S[2 * wr + 1][1]); w.w = pk2(S[2 * wr + 1][2], S[2 * wr + 1][3]);
            Pf[wr] = __builtin_bit_cast(bf16x8, w); }
        f32x4 O[8];
#pragma unroll
        for (int db = 0; db < 8; ++db) O[db] = (f32x4){0.f, 0.f, 0.f, 0.f};
#pragma unroll
        for (int stg = 0; stg < 2; ++stg) {
#pragma unroll
            for (int hb = 0; hb < 2; ++hb) {
                v4u tmp[8];
#pragma unroll
                for (int i = 0; i < 8; ++i) { const int idx = F.tid + 512 * (hb * 8 + i), ch = idx & 15, col = (idx >> 4) & 63, rw = (idx >> 10) & 3, us = idx >> 12;
                    tmp[i] = *(const v4u*)(pna + (size_t)(b * SEQ + (rs + 4 * stg + rw) * 64 + col) * LD_NA + 4096 + (2 * hp + us) * 128 + ch * 8); }
#pragma unroll
                for (int i = 0; i < 8; ++i) { const int idx = F.tid + 512 * (hb * 8 + i), ch = idx & 15, col = (idx >> 4) & 63, rw = (idx >> 10) & 3, us = idx >> 12;
                    *(LAS v4u*)(F.lds + NA_V_OFF + (us * 4 + rw) * NA_VROW + col * NA_VSTRIDE + ch * 16) = tmp[i]; }
            }
            __syncthreads();
#pragma unroll
            for (int rw = 0; rw < 4; ++rw) {
                const int wr = 4 * stg + rw;
                const unsigned base = vlds + (usub * 4 + rw) * NA_VROW + (kc0 + 4 * g + (fr >> 2)) * NA_VSTRIDE + (fr & 3) * 8;
#pragma unroll
                for (int db = 0; db < 8; db += 2) {
                    bf16x8 V0, V1;
                    tr2x2(V0, V1, base + db * 32, base + db * 32 + 16 * NA_VSTRIDE, base + db * 32 + 32, base + db * 32 + 32 + 16 * NA_VSTRIDE);
                    O[db] = MFMA16(V0, Pf[wr], O[db]); O[db + 1] = MFMA16(V1, Pf[wr], O[db + 1]);
                }
            }
            __syncthreads();
        }
#pragma unroll
        for (int db = 0; db < 8; ++db) {
            const v2u gt = *(const v2u*)(pna + (size_t)tokq * LD_NA + 6144 + h * 128 + 16 * db + 4 * g);
            v2u w; w.x = pk2(O[db][0] * inv * bflo(gt.x), O[db][1] * inv * bfhi(gt.x)); w.y = pk2(O[db][2] * inv * bflo(gt.y), O[db][3] * inv * bfhi(gt.y));
            *(v2u*)(ao + (size_t)tokq * 2048 + h * 128 + 16 * db + 4 * g) = w;
        }
    }
}

constexpr int SC_KSTRIDE = 288, SC_VSTRIDE = 96, SC_K_OFF = 0, SC_V_OFF = 128 * SC_KSTRIDE;
__device__ __forceinline__ void scan_phase(Frame& F, int L) {
    const bf16* prt = (const bf16*)(F.ws + WS_PRT); bf16* kvs = (bf16*)(F.ws + WS_KVS);
    const int lane = F.lane, fr0 = lane & 15, g0 = lane >> 4, w = F.wave;
    const unsigned klds = (unsigned)(size_t)(F.lds + SC_K_OFF), vldsb = (unsigned)(size_t)(F.lds + SC_V_OFF);
    for (int t = F.vcu; t < NSEQ * 8 * 2 * 8; t += F.G) {
        const int dvs = t & 7, dir = (t >> 3) & 1, h = (t >> 4) & 7, b = t >> 7;
        const float ld = -fabsf(F.prm[(dir ? PRM_LDB : PRM_LDF) + L * 8 + h]);
        const float cd = expf_(ld * 128.0f);
        f32x4 acc[2]; acc[0] = (f32x4){0.f, 0.f, 0.f, 0.f}; acc[1] = acc[0];
#pragma nounroll
        for (int step = 0; step < 32; ++step) {
            int fr = fr0, g = g0; asm volatile("" : "+v"(fr), "+v"(g));
            const int n = dir ? 31 - step : step; const int tokbase = b * SEQ + n * 128;
            v4u kt[4];
#pragma unroll
            for (int i = 0; i < 4; ++i) { const int idx = F.tid + 512 * i, ch = idx & 15, tok = idx >> 4;
                kt[i] = *(const v4u*)(prt + (size_t)(tokbase + tok) * LD_RT + 1024 + h * 128 + ch * 8); }
            const v4u vt = *(const v4u*)(prt + (size_t)(tokbase + (F.tid >> 2)) * LD_RT + 2048 + h * 256 + dvs * 32 + (F.tid & 3) * 8);
#pragma unroll
            for (int i = 0; i < 4; ++i) { const int idx = F.tid + 512 * i, ch = idx & 15, tok = idx >> 4;
                const float f = expf_(ld * (float)(dir ? tok : 127 - tok));
                v4u o; o.x = pk2(bflo(kt[i].x) * f, bfhi(kt[i].x) * f); o.y = pk2(bflo(kt[i].y) * f, bfhi(kt[i].y) * f); o.z = pk2(bflo(kt[i].z) * f, bfhi(kt[i].z) * f); o.w = pk2(bflo(kt[i].w) * f, bfhi(kt[i].w) * f);
                *(LAS v4u*)(F.lds + SC_K_OFF + tok * SC_KSTRIDE + ch * 16) = o; }
            *(LAS v4u*)(F.lds + SC_V_OFF + (F.tid >> 2) * SC_VSTRIDE + (F.tid & 3) * 16) = vt;
            __syncthreads();
            bf16* kout = kvs + ((size_t)(((b * 8 + h) * 2 + dir) * 32 + n) * 256) * 128;
#pragma unroll
            for (int blk = 0; blk < 2; ++blk) { v2u o; o.x = pk2(acc[blk][0], acc[blk][1]); o.y = pk2(acc[blk][2], acc[blk][3]);
                *(v2u*)(kout + (size_t)(dvs * 32 + 16 * blk + fr) * 128 + 16 * w + 4 * g) = o; }
            acc[0] *= cd; acc[1] *= cd;
#pragma unroll
            for (int ks = 0; ks < 4; ++ks) {
                const unsigned row = 32 * ks + 8 * g + (fr >> 2);
                const unsigned ka = klds + row * SC_KSTRIDE + (16 * w + 4 * (fr & 3)) * 2;
                const unsigned va = vldsb + row * SC_VSTRIDE + (4 * (fr & 3)) * 2;
                const bf16x8 Af = tr2(ka, ka + 4 * SC_KSTRIDE);
                bf16x8 B0, B1; tr2x2(B0, B1, va, va + 4 * SC_VSTRIDE, va + 32, va + 32 + 4 * SC_VSTRIDE);
                acc[0] = MFMA16(Af, B0, acc[0]); acc[1] = MFMA16(Af, B1, acc[1]);
            }
            __syncthreads();
        }
    }
}

constexpr int RO_QSTRIDE = 272, RO_VSTRIDE = 544, RO_Q_OFF = 0, RO_P_OFF = 128 * RO_QSTRIDE, RO_V_OFF = 2 * 128 * RO_QSTRIDE, RO_RED_OFF = RO_V_OFF + 128 * RO_VSTRIDE;
__device__ __forceinline__ void rout_phase(Frame& F, int L) {
    const bf16* prt = (const bf16*)(F.ws + WS_PRT); const bf16* kvs = (const bf16*)(F.ws + WS_KVS); bf16* bo = (bf16*)(F.ws + WS_BO);
    const int lane = F.lane, fr0 = lane & 15, g0 = lane >> 4, w = F.wave;
    const unsigned vlds = (unsigned)(size_t)(F.lds + RO_V_OFF);
    LAS float* red = (LAS float*)(F.lds + RO_RED_OFF);
    for (int u = F.vcu; u < NSEQ * 8 * 32; u += F.G) {
        int fr = fr0, g = g0, tid = F.tid; asm volatile("" : "+v"(fr), "+v"(g), "+v"(tid));
        const int n = u & 31, h = (u >> 5) & 7, b = u >> 8; const int tokbase = b * SEQ + n * 128;
        const float ldf = -fabsf(F.prm[PRM_LDF + L * 8 + h]), ldb = -fabsf(F.prm[PRM_LDB + L * 8 + h]);
        {
            v4u q[4], v[8];
#pragma unroll
            for (int i = 0; i < 4; ++i) { const int idx = tid + 512 * i, ch = idx & 15, tok = idx >> 4; q[i] = *(const v4u*)(prt + (size_t)(tokbase + tok) * LD_RT + h * 128 + ch * 8); }
#pragma unroll
            for (int i = 0; i < 8; ++i) { const int idx = tid + 512 * i, ch = idx & 31, tok = idx >> 5; v[i] = *(const v4u*)(prt + (size_t)(tokbase + tok) * LD_RT + 2048 + h * 256 + ch * 8); }
#pragma unroll
            for (int i = 0; i < 4; ++i) { const int idx = tid + 512 * i, ch = idx & 15, tok = idx >> 4; *(LAS v4u*)(F.lds + RO_Q_OFF + tok * RO_QSTRIDE + ch * 16) = q[i]; }
#pragma unroll
            for (int i = 0; i < 8; ++i) { const int idx = tid + 512 * i, ch = idx & 31, tok = idx >> 5; *(LAS v4u*)(F.lds + RO_V_OFF + tok * RO_VSTRIDE + ch * 16) = v[i]; }
        }
        bf16x8 Kf[4];
#pragma unroll
        for (int ks = 0; ks < 4; ++ks) Kf[ks] = *(const bf16x8*)(prt + (size_t)(tokbase + 16 * w + fr) * LD_RT + 1024 + h * 128 + 32 * ks + 8 * g);
        __syncthreads();
#pragma unroll
        for (int tb = 0; tb < 8; ++tb) {
            f32x4 s = (f32x4){0.f, 0.f, 0.f, 0.f};
#pragma unroll
            for (int ks = 0; ks < 4; ++ks) { const bf16x8 Qf = *(const LAS bf16x8*)(F.lds + RO_Q_OFF + (16 * tb + fr) * RO_QSTRIDE + (32 * ks + 8 * g) * 2); s = MFMA16(Kf[ks], Qf, s); }
            const int c = 16 * tb + fr; float p[4];
#pragma unroll
            for (int e = 0; e < 4; ++e) { const int sk = 16 * w + 4 * g + e; const int d = c - sk;
                const float dm = (d > 0) ? expf_(ldf * (float)d) : ((d < 0) ? expf_(ldb * (float)(-d)) : 2.0f);
                p[e] = s[e] * dm; }
            v2u o; o.x = pk2(p[0], p[1]); o.y = pk2(p[2], p[3]);
            *(LAS v2u*)(F.lds + RO_P_OFF + c * RO_QSTRIDE + (16 * w + 4 * g) * 2) = o;
            asm volatile("" ::: "memory");
        }
        f32x4 acc[2][8];
        {
            bf16x8 PF[2][4];
            const bf16* kf = kvs + ((size_t)(((b * 8 + h) * 2 + 0) * 32 + n) * 256) * 128;
#pragma unroll
            for (int blk = 0; blk < 2; ++blk)
#pragma unroll
                for (int ks = 0; ks < 4; ++ks) PF[blk][ks] = *(const bf16x8*)(kf + (size_t)(32 * w + 16 * blk + fr) * 128 + 32 * ks + 8 * g);
#pragma unroll
            for (int tb = 0; tb < 8; ++tb) {
                bf16x8 Qf[4];
#pragma unroll
                for (int ks = 0; ks < 4; ++ks) Qf[ks] = *(const LAS bf16x8*)(F.lds + RO_Q_OFF + (16 * tb + fr) * RO_QSTRIDE + (32 * ks + 8 * g) * 2);
                const int c = 16 * tb + fr; const float ratio = expf_(ldf * (float)(c + 1) - ldb * (float)(128 - c));
#pragma unroll
                for (int blk = 0; blk < 2; ++blk) {
                    f32x4 a = (f32x4){0.f, 0.f, 0.f, 0.f};
#pragma unroll
                    for (int ks = 0; ks < 4; ++ks) a = MFMA16(PF[blk][ks], Qf[ks], a);
                    acc[blk][tb] = a * ratio;
                }
                asm volatile("" ::: "memory");
            }
        }
        {
            bf16x8 PBk[2][4];
            const bf16* kb = kvs + ((size_t)(((b * 8 + h) * 2 + 1) * 32 + n) * 256) * 128;
#pragma unroll
            for (int blk = 0; blk < 2; ++blk)
#pragma unroll
                for (int ks = 0; ks < 4; ++ks) PBk[blk][ks] = *(const bf16x8*)(kb + (size_t)(32 * w + 16 * blk + fr) * 128 + 32 * ks + 8 * g);
#pragma unroll
            for (int tb = 0; tb < 8; ++tb) {
                bf16x8 Qf[4];
#pragma unroll
                for (int ks = 0; ks < 4; ++ks) Qf[ks] = *(const LAS bf16x8*)(F.lds + RO_Q_OFF + (16 * tb + fr) * RO_QSTRIDE + (32 * ks + 8 * g) * 2);
                const int c = 16 * tb + fr; const float eb = expf_(ldb * (float)(128 - c));
#pragma unroll
                for (int blk = 0; blk < 2; ++blk) {
                    f32x4 a = acc[blk][tb];
#pragma unroll
                    for (int ks = 0; ks < 4; ++ks) a = MFMA16(PBk[blk][ks], Qf[ks], a);
                    acc[blk][tb] = a * eb;
                }
                asm volatile("" ::: "memory");
            }
        }
        __syncthreads();
#pragma unroll
        for (int kk = 0; kk < 4; ++kk) {
            const unsigned va = vlds + (32 * kk + 8 * g + (fr >> 2)) * RO_VSTRIDE + (32 * w + 4 * (fr & 3)) * 2;
            bf16x8 V0, V1; tr2x2(V0, V1, va, va + 4 * RO_VSTRIDE, va + 32, va + 32 + 4 * RO_VSTRIDE);
#pragma unroll
            for (int tb = 0; tb < 8; ++tb) {
                const bf16x8 Pf = *(const LAS bf16x8*)(F.lds + RO_P_OFF + (16 * tb + fr) * RO_QSTRIDE + (32 * kk + 8 * g) * 2);
                acc[0][tb] = MFMA16(V0, Pf, acc[0][tb]); acc[1][tb] = MFMA16(V1, Pf, acc[1][tb]);
            }
        }
#pragma unroll
        for (int tb = 0; tb < 8; ++tb) {
            float ss = 0.f;
#pragma unroll
            for (int blk = 0; blk < 2; ++blk) { const f32x4 a = acc[blk][tb]; ss += (a[0] * a[0] + a[1] * a[1]) + (a[2] * a[2] + a[3] * a[3]); }
            ss += __shfl_xor(ss, 16); ss += __shfl_xor(ss, 32);
            if (g == 0) red[w * 128 + 16 * tb + fr] = ss;
        }
        __syncthreads();
        const float* gn = F.prm + PRM_GN + (size_t)L * 2048 + h * 256;
        f32x4 gnv[2];
#pragma unroll
        for (int blk = 0; blk < 2; ++blk) gnv[blk] = *(const f32x4*)(gn + 32 * w + 16 * blk + 4 * g);
#pragma unroll
        for (int tb = 0; tb < 8; ++tb) {
            const int c = 16 * tb + fr; float tot = 0.f;
#pragma unroll
            for (int ww = 0; ww < 8; ++ww) tot += red[ww * 128 + c];
            const float rinv = 1.0f / sqrtf(tot * (1.0f / 256.0f) + EPS);
#pragma unroll
            for (int blk = 0; blk < 2; ++blk) {
                const int dv = 32 * w + 16 * blk + 4 * g;
                const v2u gt = *(const v2u*)(prt + (size_t)(tokbase + c) * LD_RT + 4096 + h * 256 + dv);
                const f32x4 a = acc[blk][tb];
                v2u o; o.x = pk2(a[0] * rinv * gnv[blk][0] * bflo(gt.x), a[1] * rinv * gnv[blk][1] * bfhi(gt.x)); o.y = pk2(a[2] * rinv * gnv[blk][2] * bflo(gt.y), a[3] * rinv * gnv[blk][3] * bfhi(gt.y));
                *(v2u*)(bo + (size_t)(tokbase + c) * 2048 + h * 256 + dv) = o;
            }
        }
        __syncthreads();
    }
}

__device__ __forceinline__ void p6_phase(Frame& F, int L) {
    const bf16* y = (const bf16*)(F.ws + WS_Y); const float* part = (const float*)(F.ws + WS_PART); bf16* xb = (bf16*)(F.ws + WS_XBB);
    const float* lnp = F.prm + PRM_LNPOST + (size_t)L * DM;
    const int gw = F.vcu * 8 + F.wave, NGW = F.G * 8;
    for (int m = gw; m < NTOK; m += NGW) {
        const float ss = wave_sum(part[(size_t)m * 64 + F.lane]);
        const float rs = 1.0f / sqrtf(ss * (1.0f / DM) + EPS);
        const float* xr = (L == 0) ? ((m < NTOK_P) ? F.xp + (size_t)m * DM : F.xs + (size_t)(m - NTOK_P) * DM) : F.out + (size_t)m * DM;
#pragma unroll 4
        for (int j = 0; j < 16; ++j) { const int col = j * 256 + F.lane * 4;
            const f32x4 xv = *(const f32x4*)(xr + col), gv = *(const f32x4*)(lnp + col); const v2u yv = *(const v2u*)(y + (size_t)m * DM + col);
            f32x4 o; o[0] = xv[0] + bflo(yv.x) * rs * gv[0]; o[1] = xv[1] + bfhi(yv.x) * rs * gv[1]; o[2] = xv[2] + bflo(yv.y) * rs * gv[2]; o[3] = xv[3] + bfhi(yv.y) * rs * gv[3];
            *(f32x4*)(F.out + (size_t)m * DM + col) = o;
            v2u w; w.x = pk2(o[0], o[1]); w.y = pk2(o[2], o[3]); *(v2u*)(xb + (size_t)m * DM + col) = w; }
    }
}
__device__ __forceinline__ void rstd_phase(Frame& F) {
    const float* part = (const float*)(F.ws + WS_PART2); float* rstd = (float*)(F.ws + WS_RSTD);
    const int gw = F.vcu * 8 + F.wave, NGW = F.G * 8;
    for (int m = gw; m < NTOK; m += NGW) { const float ss = wave_sum(part[(size_t)m * 64 + F.lane]); if (F.lane == 0) rstd[m] = 1.0f / sqrtf(ss * (1.0f / DM) + EPS); }
}

constexpr int NPH = 18;
__global__ void __launch_bounds__(512, 2) fwd(Args args) {
    extern __shared__ __attribute__((aligned(16))) unsigned char lds_raw[];
    Frame F;
    F.lds = (LAS unsigned char*)lds_raw; F.ws = args.ws; F.out = args.out; F.xp = args.in[I_XP]; F.xs = args.in[I_XS]; F.prm = (const float*)(args.ws + WS_PRM);
    F.tid = threadIdx.x; F.lane = F.tid & 63; F.wave = __builtin_amdgcn_readfirstlane(F.tid >> 6);
    F.G = gridDim.x; F.bx = blockIdx.x; { const int bx = blockIdx.x; F.vcu = (F.G % 8 == 0) ? (bx % 8) * (F.G / 8) + bx / 8 : bx; }
    volatile LAS unsigned* MISC = (volatile LAS unsigned*)(F.lds + MISC_OFF);
    if (F.tid < 16) MISC[F.tid] = 0u;
    __syncthreads();
    unsigned* ctl = (unsigned*)(F.ws + WS_CTL);
#if MK_MULTI
    XcdBarrier bar; bar.bar = ctl + CW_BAR; bar.x = 0; bar.st = MISC;
#define GRID_BAR() do { } while (0)
#else
    XcdBarrier bar = xcd_barrier_post(ctl + CW_BAR, MISC);
#define GRID_BAR() xcd_barrier(bar)
#endif
    const int lo = args.ph_lo, hi = args.ph_hi;
#define IN(k) (lo <= (k) && (k) < hi)
#define SEAM(k) do { if (IN(k) && IN((k) + 1)) GRID_BAR(); } while (0)

    if (PH_ON(0) && IN(0)) { p0_prologue(F, args); }
    SEAM(0);
#pragma nounroll
    for (int L = 0; L < DEPTH; ++L) {
        asm volatile("" : "+v"(F.tid), "+s"(F.wave), "+s"(F.vcu), "+s"(F.G), "+s"(F.bx), "+s"(F.ws), "+s"(F.out), "+s"(F.prm));
        F.lane = F.tid & 63;
        const int pb = 1 + 9 * L;
        bf16* xba = (bf16*)(F.ws + WS_XBA); bf16* xbb = (bf16*)(F.ws + WS_XBB);
        if (PH_ON(1) && IN(pb + 0)) {
            pg8::Order<1> S; S.init(NTOK, INW, DM, F.G, F.bx); S.A[0] = (const char*)xba; S.B[0] = (const char*)((bf16*)(F.ws + WS_WIN) + (size_t)L * INW * DM);
            pg8::EpiG1 E{(bf16*)(F.ws + WS_PNA), (bf16*)(F.ws + WS_PRT), (bf16*)(F.ws + WS_PGT), (const float*)(F.ws + WS_RSTD)};
            pg8::gemm_phase(F.lds, F.tid, DM, S, E);
        }
        SEAM(pb + 0);
        if (PH_ON(2) && IN(pb + 1)) { rot_phase(F); }
        SEAM(pb + 1);
        if (IN(pb + 2)) { if (PH_ON(3)) na_phase(F, L); __syncthreads(); if (PH_ON(4)) scan_phase(F, L); }
        SEAM(pb + 2);
        if (PH_ON(5) && IN(pb + 3)) { rout_phase(F, L); }
        SEAM(pb + 3);
        if (PH_ON(6) && IN(pb + 4)) {
            pg8::Order<2> S; S.init(NTOK, DM, 2048, F.G, F.bx);
            S.A[0] = (const char*)(F.ws + WS_AO); S.A[1] = (const char*)(F.ws + WS_BO);
            S.B[0] = (const char*)((bf16*)(F.ws + WS_WPA) + (size_t)L * DM * 2048); S.B[1] = (const char*)((bf16*)(F.ws + WS_WPB) + (size_t)L * DM * 2048);
            pg8::EpiG2 E{(const bf16*)(F.ws + WS_PGT), (bf16*)(F.ws + WS_T), (bf16*)(F.ws + WS_MRG)};
            pg8::gemm_phase(F.lds, F.tid, 2048, S, E);
        }
        SEAM(pb + 4);
        if (PH_ON(7) && IN(pb + 5)) {
#if PH_ON(10)
            { pg8::Order<1> S; S.init(NTOK, DM, DM, F.G, F.bx); S.A[0] = (const char*)(F.ws + WS_MRG); S.B[0] = (const char*)((bf16*)(F.ws + WS_WOUT) + (size_t)L * DM * DM);
              pg8::EpiStore<true> E{(bf16*)(F.ws + WS_Y), (float*)(F.ws + WS_PART)};
              pg8::gemm_phase(F.lds, F.tid, DM, S, E); }
#endif
#if PH_ON(11)
            { pg8::Order<1> S; S.init(NTOK, DM, PLE, F.G, F.bx); S.A[0] = (const char*)((bf16*)(F.ws + WS_PB) + (size_t)L * NTOK * PLE); S.B[0] = (const char*)((bf16*)(F.ws + WS_WPLE) + (size_t)L * DM * PLE);
              pg8::EpiStore<false> E{(bf16*)(F.ws + WS_E), nullptr};
              pg8::gemm_phase(F.lds, F.tid, PLE, S, E); }
#endif
        }
        SEAM(pb + 5);
        if (PH_ON(8) && IN(pb + 6)) { p6_phase(F, L); }
        SEAM(pb + 6);
        if (PH_ON(9) && IN(pb + 7)) {
            pg8::Order<1> S; S.init(NTOK, DM, DM, F.G, F.bx); S.A[0] = (const char*)xbb; S.B[0] = (const char*)((bf16*)(F.ws + WS_WG) + (size_t)L * DM * DM);
            pg8::EpiG4 E{F.out, (const bf16*)(F.ws + WS_E), xba, (float*)(F.ws + WS_PART2)};
            pg8::gemm_phase(F.lds, F.tid, DM, S, E);
        }
        SEAM(pb + 7);
        if (IN(pb + 8) && L + 1 < DEPTH) { rstd_phase(F); }
        if (L + 1 < DEPTH) SEAM(pb + 8);
    }
#undef IN
#undef SEAM
}

extern "C" void kernel_launch(void* const* d_in, const int* in_sizes, int n_in, void* d_out, int out_size, void* d_ws, size_t ws_size, hipStream_t stream) {
    static int grid = 0;
    if (grid == 0) {
        if (n_in != 16 || out_size != NTOK * DM || ws_size < WS_END) { fprintf(stderr, "kernel_launch: unexpected shapes (n_in %d, out %d, ws %zu < %zu); nothing launched\n", n_in, out_size, ws_size, (size_t)WS_END); grid = -1; return; }
        int dev = 0, cus = 0, per_cu = 0;
        if (hipGetDevice(&dev) != hipSuccess || hipDeviceGetAttribute(&cus, hipDeviceAttributeMultiprocessorCount, dev) != hipSuccess) { grid = -1; return; }
        if (hipFuncSetAttribute((const void*)fwd, hipFuncAttributeMaxDynamicSharedMemorySize, LDS_BYTES) != hipSuccess) { fprintf(stderr, "kernel_launch: hipFuncSetAttribute failed\n"); grid = -1; return; }
        if (hipOccupancyMaxActiveBlocksPerMultiprocessor(&per_cu, (const void*)fwd, 512, LDS_BYTES) != hipSuccess || per_cu < 1) fprintf(stderr, "kernel_launch: occupancy query says %d\n", per_cu);
        (void)hipGetLastError();
        grid = cus;
    }
    if (grid < 0) return;
    (void)hipMemsetAsync((char*)d_ws + WS_CTL, 0, CTL_ZERO_BYTES, stream);
    Args a{};
    for (int i = 0; i < 16; ++i) a.in[i] = (const float*)d_in[i];
    a.out = (float*)d_out; a.ws = (unsigned char*)d_ws;
#if MK_MULTI
    for (int p = 0; p < NPH; ++p) { a.ph_lo = p; a.ph_hi = p + 1; hipLaunchKernelGGL(fwd, dim3(grid), dim3(512), LDS_BYTES, stream, a); }
#else
    a.ph_lo = 0; a.ph_hi = NPH; hipLaunchKernelGGL(fwd, dim3(grid), dim3(512), LDS_BYTES, stream, a);
#endif
}
```

```cpp
#include <hip/hip_runtime.h>
#include <cstdio>
#include <cstdint>

#ifndef MK_MULTI
#define MK_MULTI 0
#endif
#ifndef PH_MASK
#define PH_MASK 0xFFFFF
#endif
#define PH_ON(b) ((PH_MASK >> (b)) & 1)
#ifndef REP_MASK
#define REP_MASK 0
#endif
#define LAUNDER() asm volatile("" : "+v"(F.tid), "+s"(F.wave), "+s"(F.vcu), "+s"(F.G), "+s"(F.bx), "+s"(F.ws), "+s"(F.out), "+s"(F.prm))
#if REP_MASK
#define REP(b) _Pragma("nounroll") for (int rep_ = 0; rep_ <= ((rep_mask >> (b)) & 1); ++rep_)
#else
#define REP(b)
#endif

#define GAS __attribute__((address_space(1)))
#define LAS __attribute__((address_space(3)))
typedef unsigned short bf16;
typedef unsigned v4u __attribute__((ext_vector_type(4)));
typedef unsigned v2u __attribute__((ext_vector_type(2)));
typedef float f32x4 __attribute__((ext_vector_type(4)));
typedef float f32x2 __attribute__((ext_vector_type(2)));
typedef short bf16x8 __attribute__((ext_vector_type(8)));
typedef short s16x4 __attribute__((ext_vector_type(4)));

constexpr int DM = 4096, NTOK = 24576, NTOK_P = 16384, SEQ = 4096, NSEQ = 6, DEPTH = 2;
constexpr int INW = 22528, PLE = 256;
constexpr int LD_NA = 8192, LD_RT = 6144, LD_GT = 8192;
constexpr float EPS = 1e-6f;

constexpr size_t MiB = 1u << 20;
constexpr size_t WS_CTL = 0, CTL_ZERO_BYTES = 64 * 1024;
constexpr size_t WS_COS = 1 * MiB, WS_SIN = 2 * MiB, WS_RSTD = 3 * MiB, WS_PART = 4 * MiB, WS_PART2 = 10 * MiB;
constexpr size_t WS_WIN = 16 * MiB;
constexpr size_t WS_WPA = 368 * MiB, WS_WPB = 400 * MiB;
constexpr size_t WS_WOUT = 432 * MiB, WS_WG = 496 * MiB;
constexpr size_t WS_WPLE = 560 * MiB;
constexpr size_t WS_PB = 564 * MiB;
constexpr size_t WS_XBA = 588 * MiB, WS_XBB = 780 * MiB;
constexpr size_t WS_PNA = 972 * MiB;
constexpr size_t WS_PRT = 1356 * MiB;
constexpr size_t WS_PGT = 1644 * MiB;
constexpr size_t WS_AO = 2028 * MiB, WS_BO = 2124 * MiB;
constexpr size_t WS_MRG = 2220 * MiB, WS_Y = 2412 * MiB;
constexpr size_t WS_KVS = 2604 * MiB;
constexpr size_t WS_T = WS_PNA;
constexpr size_t WS_E = WS_PRT;
constexpr size_t WS_END = 2796 * MiB;
constexpr int CW_TMO = 0, CW_BAR = 1024;
constexpr size_t WS_PRM = 3 * MiB + 512 * 1024;
constexpr int PRM_RPB = 0, PRM_LDF = 14880, PRM_LDB = 14896, PRM_GN = 14912, PRM_LNPOST = 19008, PRM_N = 27200;

constexpr int LDS_BYTES = 155648;
constexpr int MISC_OFF = 153600;

__device__ __forceinline__ unsigned f2bf(float f) { unsigned u = __builtin_bit_cast(unsigned, f); return (u + 0x7fffu + ((u >> 16) & 1u)) >> 16; }
__device__ __forceinline__ unsigned pk2(float lo, float hi) { unsigned r; asm volatile("v_cvt_pk_bf16_f32 %0, %1, %2" : "=v"(r) : "v"(lo), "v"(hi)); return r; }
__device__ __forceinline__ float bflo(unsigned u) { return __builtin_bit_cast(float, u << 16); }
__device__ __forceinline__ float bfhi(unsigned u) { return __builtin_bit_cast(float, u & 0xffff0000u); }
__device__ __forceinline__ float sigmoidf_(float x) { return __builtin_amdgcn_rcpf(1.0f + __builtin_amdgcn_exp2f(-1.4426950408889634f * x)); }
__device__ __forceinline__ float expf_(float x) { return __builtin_amdgcn_exp2f(1.4426950408889634f * x); }
__device__ __forceinline__ float wave_sum(float v) {
#pragma unroll
    for (int o = 1; o < 64; o <<= 1) v += __shfl_xor(v, o);
    return v;
}
#define LDS_WAIT() asm volatile("s_waitcnt lgkmcnt(0)" ::: "memory")
#define VM_WAIT() asm volatile("s_waitcnt vmcnt(0)" ::: "memory")
__device__ __forceinline__ bf16x8 tr2(unsigned a0, unsigned a1) {
    s16x4 lo, hi;
    asm volatile("ds_read_b64_tr_b16 %0, %2\n\tds_read_b64_tr_b16 %1, %3\n\ts_waitcnt lgkmcnt(0)" : "=&v"(lo), "=&v"(hi) : "v"(a0), "v"(a1) : "memory");
    bf16x8 r; r[0] = lo[0]; r[1] = lo[1]; r[2] = lo[2]; r[3] = lo[3]; r[4] = hi[0]; r[5] = hi[1]; r[6] = hi[2]; r[7] = hi[3]; return r;
}
__device__ __forceinline__ void tr2x2(bf16x8& r0, bf16x8& r1, unsigned a0, unsigned a1, unsigned b0, unsigned b1) {
    s16x4 l0, h0, l1, h1;
    asm volatile("ds_read_b64_tr_b16 %0, %4\n\tds_read_b64_tr_b16 %1, %5\n\tds_read_b64_tr_b16 %2, %6\n\tds_read_b64_tr_b16 %3, %7\n\ts_waitcnt lgkmcnt(0)"
                 : "=&v"(l0), "=&v"(h0), "=&v"(l1), "=&v"(h1) : "v"(a0), "v"(a1), "v"(b0), "v"(b1) : "memory");
    r0[0] = l0[0]; r0[1] = l0[1]; r0[2] = l0[2]; r0[3] = l0[3]; r0[4] = h0[0]; r0[5] = h0[1]; r0[6] = h0[2]; r0[7] = h0[3];
    r1[0] = l1[0]; r1[1] = l1[1]; r1[2] = l1[2]; r1[3] = l1[3]; r1[4] = h1[0]; r1[5] = h1[1]; r1[6] = h1[2]; r1[7] = h1[3];
}
#define MFMA16(a, b, c) __builtin_amdgcn_mfma_f32_16x16x32_bf16((a), (b), (c), 0, 0, 0)

namespace pg8 {
#define PG8_LAS __attribute__((address_space(3)))
constexpr int BM = 256, BK = 64, HALF = 128, HTB = HALF * BK * 2, STAGE_BYTES = 8 * HTB, NXCD = 8, WGM = 8;
__host__ __device__ __forceinline__ int lds_byte(int r, int c) { const int st = (r >> 4) * 2 + (c >> 5), rr = r & 15, cc = c & 31, ob = rr * 64 + cc * 2; return st * 1024 + (ob ^ (((ob >> 9) & 1) << 5)); }
__host__ __device__ __forceinline__ void stage_rc(int b, int& R, int& C) { const int st = b / 1024, sb = b % 1024, swz = sb ^ (((sb >> 9) & 1) << 5); R = (st >> 1) * 16 + swz / 64; C = (st & 1) * 32 + (swz % 64) / 2; }
__host__ __device__ __forceinline__ int perm32(int rho) { const int n = rho >> 4, i = rho & 15; return 8 * (i >> 2) + 4 * n + (i & 3); }
struct Unit { int pm, pn, pass; };
template <int NP> struct Order {
    int nM, nN, nwg, G, c; const char* A[NP]; const char* B[NP]; size_t tstep;
    __device__ __forceinline__ void init(int M, int N, int K, int G_, int c_) { nM = M / BM; nN = N / BM; nwg = nM * nN; G = G_; c = c_; tstep = (size_t)BM * K * 2; }
    __device__ __forceinline__ bool next(int i, Unit& u) const {
        const int tile = i / NP; u.pass = i - tile * NP;
        const long L = (long)tile * G + c; if (L >= nwg) return false;
        int wgid = (int)L; { const int q = nwg / NXCD, r = nwg % NXCD, xcd = wgid % NXCD, off = wgid / NXCD; wgid = (xcd < r ? xcd * (q + 1) : r * (q + 1) + (xcd - r) * q) + off; }
        const int nig = WGM * nN, gid = wgid / nig, fm = gid * WGM, gsz = (nM - fm) < WGM ? (nM - fm) : WGM;
        u.pm = fm + ((wgid % nig) % gsz); u.pn = (wgid % nig) / gsz; return true;
    }
    __device__ __forceinline__ const char* aptr(const Unit& u) const { return ((NP == 1 || u.pass == 0) ? A[0] : A[NP - 1]) + (size_t)u.pm * tstep; }
    __device__ __forceinline__ const char* bptr(const Unit& u) const { return ((NP == 1 || u.pass == 0) ? B[0] : B[NP - 1]) + (size_t)u.pn * tstep; }
};

template <class Epi, class Sched>
__device__ __forceinline__ void gemm_phase(PG8_LAS unsigned char* lds, const int tid, const int K, const Sched& S, const Epi& E) {
    const int wid = __builtin_amdgcn_readfirstlane(tid >> 6), lane = tid & 63, wr = wid >> 2, wc = wid & 3, fr = lane & 15, fq = lane >> 4;
    const int nt = K / BK;
    unsigned voffA[2], voffB[2];
#pragma unroll
    for (int i = 0; i < 2; ++i) { int R, C; stage_rc(tid * 16 + i * 8192, R, C); const int Rb = (R & ~31) + perm32(R & 31);
        voffA[i] = (unsigned)(R * K + C) * 2u; voffB[i] = (unsigned)(Rb * K + C) * 2u; }
    const size_t kstep = (size_t)(BK * 2);
    const size_t hstep = (size_t)HALF * K * 2;
    const unsigned ldsw = (unsigned)wid * 1024u;
    const int aoff = lds_byte(wr * 64 + fr, fq * 8), boff = lds_byte(wc * 32 + fr, fq * 8);
#define PG8_SA(b, h) (((b) * 2 + (h)) * HTB)
#define PG8_SB(b, h) ((4 + (b) * 2 + (h)) * HTB)
#define PG8_STAGE(bufoff, gbase, voff) do { _Pragma("unroll") for (int _i = 0; _i < 2; ++_i) \
        __builtin_amdgcn_global_load_lds((const unsigned*)((const char*)(gbase) + (voff)[_i]), (PG8_LAS unsigned*)(lds + (bufoff) + ldsw + _i * 8192), 16, 0, 0); } while (0)
#define PG8_LDA(dst, b, h) do { _Pragma("unroll") for (int m = 0; m < 4; ++m) _Pragma("unroll") for (int k = 0; k < 2; ++k) dst[m][k] = *(const PG8_LAS bf16x8*)(lds + PG8_SA(b, h) + aoff + m * 2048 + k * 1024); } while (0)
#define PG8_LDB(dst, b, h) do { _Pragma("unroll") for (int n = 0; n < 2; ++n) _Pragma("unroll") for (int k = 0; k < 2; ++k) dst[n][k] = *(const PG8_LAS bf16x8*)(lds + PG8_SB(b, h) + boff + n * 2048 + k * 1024); } while (0)
#define PG8_MMA(ai, bj, At, Bt) do { __builtin_amdgcn_s_setprio(1); _Pragma("unroll") for (int m = 0; m < 4; ++m) _Pragma("unroll") for (int n = 0; n < 2; ++n) _Pragma("unroll") for (int k = 0; k < 2; ++k) \
        acc[ai][bj][m][n] = __builtin_amdgcn_mfma_f32_16x16x32_bf16(Bt[n][k], At[m][k], acc[ai][bj][m][n], 0, 0, 0); __builtin_amdgcn_s_setprio(0); } while (0)
#define PG8_WAIT_V(n) asm volatile("s_waitcnt vmcnt(" #n ")" ::: "memory")
#define PG8_WAIT_L(n) asm volatile("s_waitcnt lgkmcnt(" #n ")" ::: "memory")
#define PG8_BAR __builtin_amdgcn_s_barrier()
#define PG8_SCHED __builtin_amdgcn_sched_barrier(0)
    Unit cur, nxt; int ui = 0;
    if (!S.next(0, cur)) return;
    f32x4 acc[2][2][4][2];
#pragma unroll
    for (int a = 0; a < 2; ++a)
#pragma unroll
        for (int b = 0; b < 2; ++b)
#pragma unroll
            for (int m = 0; m < 4; ++m)
#pragma unroll
                for (int n = 0; n < 2; ++n) acc[a][b][m][n] = (f32x4){0.f, 0.f, 0.f, 0.f};
    bf16x8 At[4][2], B0[2][2], B1[2][2];
    const char* cA = S.aptr(cur); const char* cB = S.bptr(cur);
    PG8_STAGE(PG8_SB(0, 0), cB, voffB); PG8_STAGE(PG8_SB(0, 1), cB + hstep, voffB); PG8_STAGE(PG8_SA(0, 0), cA, voffA); PG8_STAGE(PG8_SA(0, 1), cA + hstep, voffA);
    if (wr == 1) PG8_BAR;
    PG8_WAIT_V(2); PG8_BAR;
    PG8_STAGE(PG8_SB(1, 0), cB + kstep, voffB); PG8_STAGE(PG8_SA(1, 0), cA + kstep, voffA); PG8_STAGE(PG8_SB(1, 1), cB + hstep + kstep, voffB);
    PG8_WAIT_V(6); PG8_BAR;
    for (;;) {
        const bool has_next = S.next(ui + 1, nxt);
        const char* nA = has_next ? S.aptr(nxt) : cA; const char* nB = has_next ? S.bptr(nxt) : cB;
#pragma nounroll
        for (int t = 0; t < nt; t += 2) {
            const bool last = (t == nt - 2);
            const char* a1 = cA + (size_t)(t + 1) * kstep;
            const char* a2 = last ? nA : cA + (size_t)(t + 2) * kstep; const char* b2 = last ? nB : cB + (size_t)(t + 2) * kstep;
            const char* a3 = a2 + kstep; const char* b3 = b2 + kstep;
            PG8_LDB(B0, 0, 0); PG8_LDB(B1, 0, 1); PG8_SCHED; PG8_LDA(At, 0, 0); PG8_STAGE(PG8_SA(1, 1), a1 + hstep, voffA);
            PG8_WAIT_V(8); PG8_WAIT_L(0); PG8_BAR; PG8_MMA(0, 0, At, B0); PG8_MMA(0, 1, At, B1); PG8_BAR; PG8_SCHED;
            PG8_LDA(At, 0, 1); PG8_STAGE(PG8_SB(0, 0), b2, voffB); PG8_STAGE(PG8_SB(0, 1), b2 + hstep, voffB); PG8_STAGE(PG8_SA(0, 0), a2, voffA);
            PG8_WAIT_V(8); PG8_WAIT_L(0); PG8_BAR; PG8_MMA(1, 0, At, B0); PG8_MMA(1, 1, At, B1); PG8_BAR; PG8_SCHED;
            PG8_LDB(B0, 1, 0); PG8_LDB(B1, 1, 1); PG8_SCHED; PG8_LDA(At, 1, 0); PG8_STAGE(PG8_SA(0, 1), a2 + hstep, voffA);
            PG8_WAIT_V(8); PG8_WAIT_L(0); PG8_BAR; PG8_MMA(0, 0, At, B0); PG8_MMA(0, 1, At, B1); PG8_BAR; PG8_SCHED;
            PG8_LDA(At, 1, 1); PG8_STAGE(PG8_SB(1, 0), b3, voffB); PG8_STAGE(PG8_SB(1, 1), b3 + hstep, voffB); PG8_STAGE(PG8_SA(1, 0), a3, voffA);
            PG8_WAIT_V(8); PG8_WAIT_L(0); PG8_BAR; PG8_MMA(1, 0, At, B0); PG8_MMA(1, 1, At, B1); PG8_BAR; PG8_SCHED;
        }
        if (wr == 0) PG8_BAR;
        E(acc, cur, wr, wc, fr, fq);
        if (!has_next) break;
#pragma unroll
        for (int a = 0; a < 2; ++a)
#pragma unroll
            for (int b = 0; b < 2; ++b)
#pragma unroll
                for (int m = 0; m < 4; ++m)
#pragma unroll
                    for (int n = 0; n < 2; ++n) acc[a][b][m][n] = (f32x4){0.f, 0.f, 0.f, 0.f};
        cur = nxt; cA = nA; cB = nB; ++ui;
        if (wr == 1) PG8_BAR;
    }
    PG8_WAIT_V(0);
    PG8_BAR;
#undef PG8_SA
#undef PG8_SB
#undef PG8_STAGE
#undef PG8_LDA
#undef PG8_LDB
#undef PG8_MMA
#undef PG8_WAIT_V
#undef PG8_WAIT_L
#undef PG8_BAR
#undef PG8_SCHED
}

typedef float f32x4_ __attribute__((ext_vector_type(4)));
struct EpiG1 {
    bf16 *pna, *prt, *pgt; const float* rstd;
    __device__ __forceinline__ void operator()(const f32x4 (&acc)[2][2][4][2], const Unit& u, int wr, int wc, int fr, int fq) const {
        bf16* base; int ld, colt, act;
        if (u.pn < 32) { base = pna; ld = LD_NA; colt = u.pn * BM; act = (u.pn >= 24) ? 1 : 0; }
        else if (u.pn < 56) { base = prt; ld = LD_RT; colt = (u.pn - 32) * BM; act = (u.pn >= 48) ? 1 : 0; }
        else { base = pgt; ld = LD_GT; colt = (u.pn - 56) * BM; act = 2; }
        const int row0 = u.pm * BM + wr * 64 + fr, col0 = colt + wc * 32 + 8 * fq;
        float rsv[2][4];
#pragma unroll
        for (int ai = 0; ai < 2; ++ai)
#pragma unroll
            for (int m = 0; m < 4; ++m) rsv[ai][m] = rstd[row0 + ai * HALF + m * 16];
#pragma unroll
        for (int ai = 0; ai < 2; ++ai)
#pragma unroll
            for (int m = 0; m < 4; ++m) { const int row = row0 + ai * HALF + m * 16; const float rs = rsv[ai][m]; bf16* rowp = base + (size_t)row * ld + col0;
#pragma unroll
                for (int bj = 0; bj < 2; ++bj) { f32x4 v0 = acc[ai][bj][m][0] * rs, v1 = acc[ai][bj][m][1] * rs;
                    if (act != 0) {
#pragma unroll
                        for (int j = 0; j < 4; ++j) { const float s0 = sigmoidf_(v0[j]), s1 = sigmoidf_(v1[j]); v0[j] = (act == 1) ? v0[j] * s0 : s0; v1[j] = (act == 1) ? v1[j] * s1 : s1; } }
                    v4u w; w.x = pk2(v0[0], v0[1]); w.y = pk2(v0[2], v0[3]); w.z = pk2(v1[0], v1[1]); w.w = pk2(v1[2], v1[3]);
                    *(v4u*)(rowp + bj * HALF) = w; } }
    }
};
struct EpiG2 {
    const bf16* pgt; bf16* T; bf16* mrg;
    __device__ __forceinline__ void operator()(const f32x4 (&acc)[2][2][4][2], const Unit& u, int wr, int wc, int fr, int fq) const {
        const int row0 = u.pm * BM + wr * 64 + fr, col0 = u.pn * BM + wc * 32 + 8 * fq;
        const bool p1 = (u.pass == 1);
        bf16* const dstb = (bf16*)((uintptr_t)T + (uintptr_t)u.pass * ((uintptr_t)mrg - (uintptr_t)T));
        v4u gt[2], tt[2], gn[2], tn[2];
#pragma unroll
        for (int bj = 0; bj < 2; ++bj) { gt[bj] = *(const v4u*)(pgt + (size_t)row0 * LD_GT + u.pass * DM + col0 + bj * HALF); tt[bj] = p1 ? *(const v4u*)(T + (size_t)row0 * DM + col0 + bj * HALF) : (v4u){0u, 0u, 0u, 0u}; }
#pragma unroll
        for (int i = 0; i < 8; ++i) { const int row = row0 + (i >> 2) * HALF + (i & 3) * 16, rown = row0 + ((i + 1) >> 2) * HALF + ((i + 1) & 3) * 16;
            if (i < 7) {
#pragma unroll
                for (int bj = 0; bj < 2; ++bj) { gn[bj] = *(const v4u*)(pgt + (size_t)rown * LD_GT + u.pass * DM + col0 + bj * HALF); tn[bj] = p1 ? *(const v4u*)(T + (size_t)rown * DM + col0 + bj * HALF) : (v4u){0u, 0u, 0u, 0u}; } }
#pragma unroll
            for (int bj = 0; bj < 2; ++bj) { const int col = col0 + bj * HALF; const v4u g = gt[bj], t = tt[bj];
                f32x4 v0 = acc[i >> 2][bj][i & 3][0], v1 = acc[i >> 2][bj][i & 3][1];
                v0[0] = v0[0] * bflo(g.x) + bflo(t.x); v0[1] = v0[1] * bfhi(g.x) + bfhi(t.x); v0[2] = v0[2] * bflo(g.y) + bflo(t.y); v0[3] = v0[3] * bfhi(g.y) + bfhi(t.y);
                v1[0] = v1[0] * bflo(g.z) + bflo(t.z); v1[1] = v1[1] * bfhi(g.z) + bfhi(t.z); v1[2] = v1[2] * bflo(g.w) + bflo(t.w); v1[3] = v1[3] * bfhi(g.w) + bfhi(t.w);
                v4u w; w.x = pk2(v0[0], v0[1]); w.y = pk2(v0[2], v0[3]); w.z = pk2(v1[0], v1[1]); w.w = pk2(v1[2], v1[3]);
                *(v4u*)(dstb + (size_t)row * DM + col) = w; }
            asm volatile("" ::: "memory");
#pragma unroll
            for (int bj = 0; bj < 2; ++bj) { gt[bj] = gn[bj]; tt[bj] = tn[bj]; } }
    }
};
template <bool STATS> struct EpiStore {
    bf16* O; float* part;
    __device__ __forceinline__ void operator()(const f32x4 (&acc)[2][2][4][2], const Unit& u, int wr, int wc, int fr, int fq) const {
        const int row0 = u.pm * BM + wr * 64 + fr, col0 = u.pn * BM + wc * 32 + 8 * fq;
#pragma unroll
        for (int ai = 0; ai < 2; ++ai)
#pragma unroll
            for (int m = 0; m < 4; ++m) { const int row = row0 + ai * HALF + m * 16; float ss = 0.f;
#pragma unroll
                for (int bj = 0; bj < 2; ++bj) { const f32x4 v0 = acc[ai][bj][m][0], v1 = acc[ai][bj][m][1];
                    if (STATS) ss += (v0[0] * v0[0] + v0[1] * v0[1]) + (v0[2] * v0[2] + v0[3] * v0[3]) + (v1[0] * v1[0] + v1[1] * v1[1]) + (v1[2] * v1[2] + v1[3] * v1[3]);
                    v4u w; w.x = pk2(v0[0], v0[1]); w.y = pk2(v0[2], v0[3]); w.z = pk2(v1[0], v1[1]); w.w = pk2(v1[2], v1[3]);
                    *(v4u*)(O + (size_t)row * DM + col0 + bj * HALF) = w; }
                if (STATS) { ss += __shfl_xor(ss, 16); ss += __shfl_xor(ss, 32); if (fq == 0) part[(size_t)row * 64 + u.pn * 4 + wc] = ss; } }
    }
};
template <bool FINAL> struct EpiG4 {
    const bf16* x1b; const bf16* E; bf16* xb; float* part; float* out;
    __device__ __forceinline__ void operator()(const f32x4 (&acc)[2][2][4][2], const Unit& u, int wr, int wc, int fr, int fq) const {
        const int row0 = u.pm * BM + wr * 64 + fr, col0 = u.pn * BM + wc * 32 + 8 * fq;
        v4u ec[2], en[2], xc[2], xn[2];
#pragma unroll
        for (int bj = 0; bj < 2; ++bj) { const size_t off = (size_t)row0 * DM + col0 + bj * HALF; ec[bj] = *(const v4u*)(E + off); xc[bj] = *(const v4u*)(x1b + off); }
#pragma unroll
        for (int i = 0; i < 8; ++i) { const int row = row0 + (i >> 2) * HALF + (i & 3) * 16, rown = row0 + ((i + 1) >> 2) * HALF + ((i + 1) & 3) * 16; float ss = 0.f;
            if (i < 7) {
#pragma unroll
                for (int bj = 0; bj < 2; ++bj) { const size_t off = (size_t)rown * DM + col0 + bj * HALF; en[bj] = *(const v4u*)(E + off); xn[bj] = *(const v4u*)(x1b + off); } }
#pragma unroll
            for (int bj = 0; bj < 2; ++bj) { const size_t off = (size_t)row * DM + col0 + bj * HALF;
                const v4u e = ec[bj], x = xc[bj];
                const f32x4 a0 = acc[i >> 2][bj][i & 3][0], a1 = acc[i >> 2][bj][i & 3][1]; f32x4 v0, v1;
                v0[0] = bflo(x.x) + sigmoidf_(a0[0]) * bflo(e.x); v0[1] = bfhi(x.x) + sigmoidf_(a0[1]) * bfhi(e.x); v0[2] = bflo(x.y) + sigmoidf_(a0[2]) * bflo(e.y); v0[3] = bfhi(x.y) + sigmoidf_(a0[3]) * bfhi(e.y);
                v1[0] = bflo(x.z) + sigmoidf_(a1[0]) * bflo(e.z); v1[1] = bfhi(x.z) + sigmoidf_(a1[1]) * bfhi(e.z); v1[2] = bflo(x.w) + sigmoidf_(a1[2]) * bflo(e.w); v1[3] = bfhi(x.w) + sigmoidf_(a1[3]) * bfhi(e.w);
                if (FINAL) { *(f32x4*)(out + off) = v0; *(f32x4*)(out + off + 4) = v1; }
                else { ss += (v0[0] * v0[0] + v0[1] * v0[1]) + (v0[2] * v0[2] + v0[3] * v0[3]) + (v1[0] * v1[0] + v1[1] * v1[1]) + (v1[2] * v1[2] + v1[3] * v1[3]);
                    v4u w; w.x = pk2(v0[0], v0[1]); w.y = pk2(v0[2], v0[3]); w.z = pk2(v1[0], v1[1]); w.w = pk2(v1[2], v1[3]);
                    *(v4u*)(xb + off) = w; } }
            if (!FINAL) { ss += __shfl_xor(ss, 16); ss += __shfl_xor(ss, 32); if (fq == 0) part[(size_t)row * 64 + u.pn * 4 + wc] = ss; }
            asm volatile("" ::: "memory");
#pragma unroll
            for (int bj = 0; bj < 2; ++bj) { ec[bj] = en[bj]; xc[bj] = xn[bj]; } }
    }
};
}

#define XB_TMO      128
#define XB_XCNT(j)  (256  + 64 * (j))
#define XB_XSUB(j)  (1280 + 64 * (j))
#define XB_XGEN(j)  (2304 + 64 * (j))
#define XB_TOP      3328
#define XB_TOPGEN   3392
#define XCD_BAR_WORDS 3456
#define XB_SPIN_CAP (1u << 22)
__device__ __forceinline__ unsigned xb_ld(unsigned* p)              { return __hip_atomic_load(p, __ATOMIC_RELAXED, __HIP_MEMORY_SCOPE_AGENT); }
__device__ __forceinline__ unsigned xb_add(unsigned* p, unsigned v) { return __hip_atomic_fetch_add(p, v, __ATOMIC_RELAXED, __HIP_MEMORY_SCOPE_AGENT); }
__device__ __forceinline__ unsigned xb_xcc_id() { return (unsigned)__builtin_amdgcn_s_getreg((3 << 11) | 20) & 0xFu; }
#define XB_SPIN(cond, bar) do { unsigned _sp = 0; while (cond) { __builtin_amdgcn_s_sleep(1); \
    if ((++_sp & 255u) == 0u) { if (xb_ld(&(bar)[XB_TMO])) break; if (_sp > XB_SPIN_CAP) { atomicAdd(&(bar)[XB_TMO], 1u); break; } } } } while (0)
struct XcdBarrier { unsigned* bar; unsigned x; volatile LAS unsigned* st; };
__device__ __forceinline__ XcdBarrier xcd_barrier_post(unsigned* bar, volatile LAS unsigned* st) {
    XcdBarrier b; b.bar = bar; b.x = xb_xcc_id(); b.st = st;
    if (threadIdx.x == 0) (void)xb_add(&bar[XB_XCNT(b.x)], 1u);
    return b;
}
__device__ __forceinline__ void xcd_barrier_complete(unsigned* bar, unsigned x, unsigned& nloc, unsigned& nx) {
    const unsigned G = gridDim.x * gridDim.y * gridDim.z;
    unsigned sum, cnt, mine, sp = 0u;
    for (;;) {
        sum = 0u; cnt = 0u; mine = 0u;
#pragma unroll
        for (unsigned j = 0; j < 16; ++j) { const unsigned c = xb_ld(&bar[XB_XCNT(j)]); sum += c; cnt += (c > 0u) ? 1u : 0u; mine = (j == x) ? c : mine; }
        if (sum == G) break;
        __builtin_amdgcn_s_sleep(1);
        if ((++sp & 255u) == 0u) { if (xb_ld(&bar[XB_TMO])) break; if (sp > XB_SPIN_CAP) { atomicAdd(&bar[XB_TMO], 1u); break; } }
    }
    nloc = mine > 0u ? mine : 1u; nx = cnt > 0u ? cnt : 1u;
}
__device__ __forceinline__ void xcd_barrier(const XcdBarrier& b) {
    asm volatile("s_waitcnt vmcnt(0)" ::: "memory");
    __syncthreads();
    if (threadIdx.x == 0) {
        unsigned* bar = b.bar;
        __builtin_amdgcn_s_waitcnt(0);
        unsigned nloc = b.st[0], nx = b.st[1];
        if (nloc == 0u) { xcd_barrier_complete(bar, b.x, nloc, nx); b.st[0] = nloc; b.st[1] = nx; }
        const unsigned old = xb_add(&bar[XB_XSUB(b.x)], 1u);
        const unsigned gen = old / nloc;
        if (old + 1u == (gen + 1u) * nloc) {
            __builtin_amdgcn_fence(__ATOMIC_RELEASE, "agent");
            asm volatile("s_waitcnt vmcnt(0)" ::: "memory");
            const unsigned og = xb_add(&bar[XB_TOP], 1u);
            const unsigned tg = og / nx;
            if (og + 1u == (tg + 1u) * nx) xb_add(&bar[XB_TOPGEN], 1u);
            else XB_SPIN(xb_ld(&bar[XB_TOPGEN]) == tg, bar);
            __builtin_amdgcn_fence(__ATOMIC_ACQUIRE, "agent");
            xb_add(&bar[XB_XGEN(b.x)], 1u);
            asm volatile("s_waitcnt vmcnt(0)" ::: "memory");
        } else {
            XB_SPIN(xb_ld(&bar[XB_XGEN(b.x)]) == gen, bar);
            __builtin_amdgcn_fence(__ATOMIC_ACQUIRE, "agent");
            asm volatile("s_waitcnt vmcnt(0)" ::: "memory");
        }
    }
    __syncthreads();
}

struct Args { const float* in[16]; float* out; unsigned char* ws; int ph_lo, ph_hi, rep, pad; };
struct Frame {
    LAS unsigned char* lds; unsigned char* ws; const float* xp; const float* xs; const float* prm; float* out;
    int tid, lane, wave, vcu, G, bx;
};
enum { I_XP = 0, I_XS, I_PP, I_PS, I_WIN, I_LNPRE, I_LNPOST, I_RPB, I_LDF, I_LDB, I_GN, I_WPA, I_WPB, I_WOUT, I_WPLE, I_WG };

__device__ __forceinline__ void p0_transpose_item(const float* W, int K, int N, bf16* WT, const float* scale, int item, int lane) {
    const int nblk = N / 32, kb = item / nblk, nb = item % nblk, nq = lane & 7, kg = lane >> 3;
    const int k = 64 * kb + 8 * kg, n = 32 * nb + 4 * nq;
    f32x4 v[8];
#pragma unroll
    for (int j = 0; j < 8; ++j) v[j] = __builtin_nontemporal_load((const f32x4*)(W + (size_t)(k + j) * N + n));
    if (scale) { const f32x4 s0 = *(const f32x4*)(scale + k), s1 = *(const f32x4*)(scale + k + 4);
#pragma unroll
        for (int j = 0; j < 4; ++j) { v[j] *= s0[j]; v[4 + j] *= s1[j]; } }
#pragma unroll
    for (int i = 0; i < 4; ++i) { v4u o; o.x = pk2(v[0][i], v[1][i]); o.y = pk2(v[2][i], v[3][i]); o.z = pk2(v[4][i], v[5][i]); o.w = pk2(v[6][i], v[7][i]);
        *(v4u*)(WT + (size_t)(n + i) * K + k) = o; }
}
__device__ __forceinline__ void p0_prologue(Frame& F, const Args& A) {
    const int gw = F.vcu * 8 + F.wave, NGW = F.G * 8;
    constexpr int I_IN = (DM / 64) * (INW / 32), I_PA = (2048 / 64) * (DM / 32), I_O = (DM / 64) * (DM / 32), I_PL = (PLE / 64) * (DM / 32);
    constexpr int PER_L = I_IN + 2 * I_PA + 2 * I_O + I_PL;
    for (int it = gw; it < 2 * PER_L; it += NGW) {
        const int L = it / PER_L; int r = it - L * PER_L;
        if (r < I_IN) { p0_transpose_item(A.in[I_WIN] + (size_t)L * DM * INW, DM, INW, (bf16*)(F.ws + WS_WIN) + (size_t)L * INW * DM, A.in[I_LNPRE] + L * DM, r, F.lane); continue; } r -= I_IN;
        if (r < I_PA) { p0_transpose_item(A.in[I_WPA] + (size_t)L * 2048 * DM, 2048, DM, (bf16*)(F.ws + WS_WPA) + (size_t)L * DM * 2048, nullptr, r, F.lane); continue; } r -= I_PA;
        if (r < I_PA) { p0_transpose_item(A.in[I_WPB] + (size_t)L * 2048 * DM, 2048, DM, (bf16*)(F.ws + WS_WPB) + (size_t)L * DM * 2048, nullptr, r, F.lane); continue; } r -= I_PA;
        if (r < I_O) { p0_transpose_item(A.in[I_WOUT] + (size_t)L * DM * DM, DM, DM, (bf16*)(F.ws + WS_WOUT) + (size_t)L * DM * DM, nullptr, r, F.lane); continue; } r -= I_O;
        if (r < I_O) { p0_transpose_item(A.in[I_WG] + (size_t)L * DM * DM, DM, DM, (bf16*)(F.ws + WS_WG) + (size_t)L * DM * DM, nullptr, r, F.lane); continue; } r -= I_O;
        p0_transpose_item(A.in[I_WPLE] + (size_t)L * PLE * DM, PLE, DM, (bf16*)(F.ws + WS_WPLE) + (size_t)L * DM * PLE, nullptr, r, F.lane);
    }
    float* rstd = (float*)(F.ws + WS_RSTD); bf16* xb = (bf16*)(F.ws + WS_XBA);
    for (int m = gw; m < NTOK; m += NGW) {
        const float* xr = (m < NTOK_P) ? A.in[I_XP] + (size_t)m * DM : A.in[I_XS] + (size_t)(m - NTOK_P) * DM;
        float s = 0.f;
#pragma unroll 4
        for (int j = 0; j < 16; ++j) { const f32x4 v = *(const f32x4*)(xr + j * 256 + F.lane * 4); s += (v[0] * v[0] + v[1] * v[1]) + (v[2] * v[2] + v[3] * v[3]);
            v2u w; w.x = pk2(v[0], v[1]); w.y = pk2(v[2], v[3]); *(v2u*)(xb + (size_t)m * DM + j * 256 + F.lane * 4) = w; }
        s = wave_sum(s);
        if (F.lane == 0) rstd[m] = 1.0f / sqrtf(s * (1.0f / DM) + EPS);
    }
    bf16* pb = (bf16*)(F.ws + WS_PB);
    for (int i = gw * 64 + F.lane; i < 2 * NTOK * (PLE / 4); i += NGW * 64) {
        const int L = i / (NTOK * (PLE / 4)), r = i - L * (NTOK * (PLE / 4)), m = r / (PLE / 4), c4 = r % (PLE / 4);
        const float* src = (m < NTOK_P) ? A.in[I_PP] + ((size_t)L * NTOK_P + m) * PLE : A.in[I_PS] + ((size_t)L * (NTOK - NTOK_P) + (m - NTOK_P)) * PLE;
        const f32x4 v = *(const f32x4*)(src + c4 * 4); v2u w; w.x = pk2(v[0], v[1]); w.y = pk2(v[2], v[3]);
        *(v2u*)(pb + ((size_t)L * NTOK + m) * PLE + c4 * 4) = w;
    }
    { float* prm = (float*)(F.ws + WS_PRM);
      for (int i = gw * 64 + F.lane; i < PRM_N; i += NGW * 64) {
          float v;
          if (i < PRM_LDF) v = A.in[I_RPB][i]; else if (i < PRM_LDB) v = A.in[I_LDF][i - PRM_LDF]; else if (i < PRM_GN) v = A.in[I_LDB][i - PRM_LDB];
          else if (i < PRM_LNPOST) v = A.in[I_GN][i - PRM_GN]; else v = A.in[I_LNPOST][i - PRM_LNPOST];
          prm[i] = v; } }
    float* ct = (float*)(F.ws + WS_COS); float* st = (float*)(F.ws + WS_SIN);
    for (int i = gw * 64 + F.lane; i < SEQ * 64; i += NGW * 64) {
        const int pos = i >> 6, k = i & 63;
        const float inv = __builtin_amdgcn_exp2f(-(float)k * 0.20762050593046014f);
        const float ang = (float)pos * inv;
        const float n = rintf(ang * 0.15915494f);
        const float fr_ = __builtin_fmaf(ang, 0.15915494f, -n) + ang * 6.4206e-9f;
        ct[i] = __builtin_amdgcn_cosf(fr_); st[i] = __builtin_amdgcn_sinf(fr_);
    }
}

__device__ __forceinline__ void rot_phase(Frame& F) {
    bf16* prt = (bf16*)(F.ws + WS_PRT); const float* ct = (const float*)(F.ws + WS_COS); const float* st = (const float*)(F.ws + WS_SIN);
    const int gt = (F.vcu * 8 + F.wave) * 64 + F.lane, NT = F.G * 512;
    for (int i = gt; i < NTOK * 128; i += NT) {
        const int m = i >> 7, r = i & 127, which = r >> 6, h = (r >> 3) & 7, c = r & 7, pos = m & (SEQ - 1);
        bf16* p = prt + (size_t)m * LD_RT + which * 1024 + h * 128 + c * 8;
        const v4u lo = *(const v4u*)p, hi = *(const v4u*)(p + 64);
        const f32x4 c0 = *(const f32x4*)(ct + pos * 64 + c * 8), c1 = *(const f32x4*)(ct + pos * 64 + c * 8 + 4);
        const f32x4 s0 = *(const f32x4*)(st + pos * 64 + c * 8), s1 = *(const f32x4*)(st + pos * 64 + c * 8 + 4);
        const float sc = which ? 0.08838834764831845f : 1.0f;
        float a[8] = {bflo(lo.x), bfhi(lo.x), bflo(lo.y), bfhi(lo.y), bflo(lo.z), bfhi(lo.z), bflo(lo.w), bfhi(lo.w)};
        float b[8] = {bflo(hi.x), bfhi(hi.x), bflo(hi.y), bfhi(hi.y), bflo(hi.z), bfhi(hi.z), bflo(hi.w), bfhi(hi.w)};
        const float cs[8] = {c0[0], c0[1], c0[2], c0[3], c1[0], c1[1], c1[2], c1[3]}, sn[8] = {s0[0], s0[1], s0[2], s0[3], s1[0], s1[1], s1[2], s1[3]};
        float ol[8], oh[8];
#pragma unroll
        for (int j = 0; j < 8; ++j) { ol[j] = (a[j] * cs[j] - b[j] * sn[j]) * sc; oh[j] = (a[j] * sn[j] + b[j] * cs[j]) * sc; }
        v4u wl, wh; wl.x = pk2(ol[0], ol[1]); wl.y = pk2(ol[2], ol[3]); wl.z = pk2(ol[4], ol[5]); wl.w = pk2(ol[6], ol[7]);
        wh.x = pk2(oh[0], oh[1]); wh.y = pk2(oh[2], oh[3]); wh.z = pk2(oh[4], oh[5]); wh.w = pk2(oh[6], oh[7]);
        *(v4u*)p = wl; *(v4u*)(p + 64) = wh;
    }
}

constexpr int NA_VSTRIDE = 288;
constexpr int NA_BIAS_OFF = 0, NA_V_OFF = 4096, NA_VROW = 64 * NA_VSTRIDE;
__device__ __forceinline__ void na_phase(Frame& F, int L) {
    const bf16* pna = (const bf16*)(F.ws + WS_PNA); bf16* ao = (bf16*)(F.ws + WS_AO);
    const float* rpb = F.prm + PRM_RPB + (size_t)L * 16 * 465;
    const int lane = F.lane, fr0 = lane & 15, g0 = lane >> 4, usub = F.wave >> 2, qblk = F.wave & 3;
    LAS float* lb = (LAS float*)(F.lds + NA_BIAS_OFF);
    const unsigned vlds = (unsigned)(size_t)(F.lds + NA_V_OFF);
    const float scale = 0.08838834764831845f;
    for (int up = F.vcu; up < NSEQ * 64 * 8; up += F.G) {
        int fr = fr0, g = g0; asm volatile("" : "+v"(fr), "+v"(g));
        const int b = up >> 9, hp = (up >> 6) & 7, r = up & 63, h = 2 * hp + usub;
        const int rs = min(max(r - 4, 0), 56);
        const int tokq = b * SEQ + r * 64 + 16 * qblk + fr;
        for (int i = F.tid; i < 2 * 465; i += 512) lb[(i >= 465 ? 512 : 0) + (i >= 465 ? i - 465 : i)] = rpb[(size_t)(2 * hp) * 465 + i];
        bf16x8 Qf[4];
#pragma unroll
        for (int ks = 0; ks < 4; ++ks) Qf[ks] = *(const bf16x8*)(pna + (size_t)tokq * LD_NA + h * 128 + 32 * ks + 8 * g);
        const int kc0 = min(max(16 * qblk - 8, 0), 32);
        f32x4 S[16];
#pragma unroll
        for (int kb = 0; kb < 16; ++kb) {
            const int wr = kb >> 1, cb = kb & 1;
            const bf16* kp = pna + (size_t)(b * SEQ + (rs + wr) * 64 + kc0 + 16 * cb + fr) * LD_NA + 2048 + h * 128 + 8 * g;
            bf16x8 Kf[4];
#pragma unroll
            for (int ks = 0; ks < 4; ++ks) Kf[ks] = *(const bf16x8*)(kp + 32 * ks);
            f32x4 a = (f32x4){0.f, 0.f, 0.f, 0.f};
#pragma unroll
            for (int ks = 0; ks < 4; ++ks) a = MFMA16(Kf[ks], Qf[ks], a);
            S[kb] = a;
        }
        __syncthreads();
        const int c = 16 * qblk + fr, cs = min(max(c - 8, 0), 48);
        const LAS float* lbh = lb + usub * 512;
        float mx = -3.0e38f;
#pragma unroll
        for (int kb = 0; kb < 16; ++kb) {
            const int wr = kb >> 1, cb = kb & 1;
#pragma unroll
            for (int e = 0; e < 4; ++e) {
                const int kc = kc0 + 16 * cb + 4 * g + e; const bool valid = (kc >= cs) && (kc < cs + 16);
                const int bi = (rs + wr - r + 7) * 31 + (kc - c + 15);
                const float bias = valid ? lbh[bi] : 0.f;
                const float s = valid ? S[kb][e] * scale + bias : -3.0e38f;
                S[kb][e] = s; mx = fmaxf(mx, s);
            }
        }
        mx = fmaxf(mx, __shfl_xor(mx, 16)); mx = fmaxf(mx, __shfl_xor(mx, 32));
        float sum = 0.f;
#pragma unroll
        for (int kb = 0; kb < 16; ++kb)
#pragma unroll
            for (int e = 0; e < 4; ++e) { const float p = (S[kb][e] > -1.0e38f) ? expf_(S[kb][e] - mx) : 0.f; S[kb][e] = p; sum += p; }
        sum += __shfl_xor(sum, 16); sum += __shfl_xor(sum, 32);
        const float inv = 1.0f / sum;
        bf16x8 Pf[8];
#pragma unroll
        for (int wr = 0; wr < 8; ++wr) { v4u w; w.x = pk2(S[2 * wr][0], S[2 * wr][1]); w.y = pk2(S[2 * wr][2], S[2 * wr][3]); w.z = pk2(S[2 * wr + 1][0], S[2 * wr + 1][1]); w.w = pk2(S[2 * wr + 1][2], S[2 * wr + 1][3]);
            Pf[wr] = __builtin_bit_cast(bf16x8, w); }
        f32x4 O[8];
#pragma unroll
        for (int db = 0; db < 8; ++db) O[db] = (f32x4){0.f, 0.f, 0.f, 0.f};
#pragma unroll
        for (int stg = 0; stg < 2; ++stg) {
#pragma unroll
            for (int hb = 0; hb < 2; ++hb) {
                v4u tmp[8];
#pragma unroll
                for (int i = 0; i < 8; ++i) { const int idx = F.tid + 512 * (hb * 8 + i), ch = idx & 15, col = (idx >> 4) & 63, rw = (idx >> 10) & 3, us = idx >> 12;
                    tmp[i] = *(const v4u*)(pna + (size_t)(b * SEQ + (rs + 4 * stg + rw) * 64 + col) * LD_NA + 4096 + (2 * hp + us) * 128 + ch * 8); }
#pragma unroll
                for (int i = 0; i < 8; ++i) { const int idx = F.tid + 512 * (hb * 8 + i), ch = idx & 15, col = (idx >> 4) & 63, rw = (idx >> 10) & 3, us = idx >> 12;
                    *(LAS v4u*)(F.lds + NA_V_OFF + (us * 4 + rw) * NA_VROW + col * NA_VSTRIDE + ch * 16) = tmp[i]; }
            }
            __syncthreads();
#pragma unroll
            for (int rw = 0; rw < 4; ++rw) {
                const int wr = 4 * stg + rw;
                const unsigned base = vlds + (usub * 4 + rw) * NA_VROW + (kc0 + 4 * g + (fr >> 2)) * NA_VSTRIDE + (fr & 3) * 8;
#pragma unroll
                for (int db = 0; db < 8; db += 2) {
                    bf16x8 V0, V1;
                    tr2x2(V0, V1, base + db * 32, base + db * 32 + 16 * NA_VSTRIDE, base + db * 32 + 32, base + db * 32 + 32 + 16 * NA_VSTRIDE);
                    O[db] = MFMA16(V0, Pf[wr], O[db]); O[db + 1] = MFMA16(V1, Pf[wr], O[db + 1]);
                }
            }
            __syncthreads();
        }
#pragma unroll
        for (int db = 0; db < 8; ++db) {
            const v2u gt = *(const v2u*)(pna + (size_t)tokq * LD_NA + 6144 + h * 128 + 16 * db + 4 * g);
            v2u w; w.x = pk2(O[db][0] * inv * bflo(gt.x), O[db][1] * inv * bfhi(gt.x)); w.y = pk2(O[db][2] * inv * bflo(gt.y), O[db][3] * inv * bfhi(gt.y));
            *(v2u*)(ao + (size_t)tokq * 2048 + h * 128 + 16 * db + 4 * g) = w;
        }
    }
}

constexpr int SC_KSTRIDE = 288, SC_VSTRIDE = 96, SC_K_OFF = 0, SC_V_OFF = 128 * SC_KSTRIDE;
__device__ __forceinline__ void scan_phase(Frame& F, int L) {
    const bf16* prt = (const bf16*)(F.ws + WS_PRT); bf16* kvs = (bf16*)(F.ws + WS_KVS);
    const int lane = F.lane, fr0 = lane & 15, g0 = lane >> 4, w = F.wave;
    const unsigned klds = (unsigned)(size_t)(F.lds + SC_K_OFF), vldsb = (unsigned)(size_t)(F.lds + SC_V_OFF);
    for (int t = F.vcu; t < NSEQ * 8 * 2 * 8; t += F.G) {
        const int dvs = t & 7, dir = (t >> 3) & 1, h = (t >> 4) & 7, b = t >> 7;
        const float ld = -fabsf(F.prm[(dir ? PRM_LDB : PRM_LDF) + L * 8 + h]);
        const float cd = expf_(ld * 128.0f);
        f32x4 acc[2]; acc[0] = (f32x4){0.f, 0.f, 0.f, 0.f}; acc[1] = acc[0];
#pragma nounroll
        for (int step = 0; step < 32; ++step) {
            int fr = fr0, g = g0; asm volatile("" : "+v"(fr), "+v"(g));
            const int n = dir ? 31 - step : step; const int tokbase = b * SEQ + n * 128;
            v4u kt[4];
#pragma unroll
            for (int i = 0; i < 4; ++i) { const int idx = F.tid + 512 * i, ch = idx & 15, tok = idx >> 4;
                kt[i] = *(const v4u*)(prt + (size_t)(tokbase + tok) * LD_RT + 1024 + h * 128 + ch * 8); }
            const v4u vt = *(const v4u*)(prt + (size_t)(tokbase + (F.tid >> 2)) * LD_RT + 2048 + h * 256 + dvs * 32 + (F.tid & 3) * 8);
#pragma unroll
            for (int i = 0; i < 4; ++i) { const int idx = F.tid + 512 * i, ch = idx & 15, tok = idx >> 4;
                const float f = expf_(ld * (float)(dir ? tok : 127 - tok));
                v4u o; o.x = pk2(bflo(kt[i].x) * f, bfhi(kt[i].x) * f); o.y = pk2(bflo(kt[i].y) * f, bfhi(kt[i].y) * f); o.z = pk2(bflo(kt[i].z) * f, bfhi(kt[i].z) * f); o.w = pk2(bflo(kt[i].w) * f, bfhi(kt[i].w) * f);
                *(LAS v4u*)(F.lds + SC_K_OFF + tok * SC_KSTRIDE + ch * 16) = o; }
            *(LAS v4u*)(F.lds + SC_V_OFF + (F.tid >> 2) * SC_VSTRIDE + (F.tid & 3) * 16) = vt;
            __syncthreads();
            bf16* kout = kvs + ((size_t)(((b * 8 + h) * 2 + dir) * 32 + n) * 256) * 128;
#pragma unroll
            for (int blk = 0; blk < 2; ++blk) { v2u o; o.x = pk2(acc[blk][0], acc[blk][1]); o.y = pk2(acc[blk][2], acc[blk][3]);
                *(v2u*)(kout + (size_t)(dvs * 32 + 16 * blk + fr) * 128 + 16 * w + 4 * g) = o; }
            acc[0] *= cd; acc[1] *= cd;
#pragma unroll
            for (int ks = 0; ks < 4; ++ks) {
                const unsigned row = 32 * ks + 8 * g + (fr >> 2);
                const unsigned ka = klds + row * SC_KSTRIDE + (16 * w + 4 * (fr & 3)) * 2;
                const unsigned va = vldsb + row * SC_VSTRIDE + (4 * (fr & 3)) * 2;
                const bf16x8 Af = tr2(ka, ka + 4 * SC_KSTRIDE);
                bf16x8 B0, B1; tr2x2(B0, B1, va, va + 4 * SC_VSTRIDE, va + 32, va + 32 + 4 * SC_VSTRIDE);
                acc[0] = MFMA16(Af, B0, acc[0]); acc[1] = MFMA16(Af, B1, acc[1]);
            }
            __syncthreads();
        }
    }
}

constexpr int RO_QSTRIDE = 272, RO_VSTRIDE = 544, RO_Q_OFF = 0, RO_P_OFF = 128 * RO_QSTRIDE, RO_V_OFF = 2 * 128 * RO_QSTRIDE, RO_RED_OFF = RO_V_OFF + 128 * RO_VSTRIDE;
__device__ __forceinline__ void rout_phase(Frame& F, int L) {
    const bf16* prt = (const bf16*)(F.ws + WS_PRT); const bf16* kvs = (const bf16*)(F.ws + WS_KVS); bf16* bo = (bf16*)(F.ws + WS_BO);
    const int lane = F.lane, fr0 = lane & 15, g0 = lane >> 4, w = F.wave;
    const unsigned vlds = (unsigned)(size_t)(F.lds + RO_V_OFF);
    LAS float* red = (LAS float*)(F.lds + RO_RED_OFF);
    for (int u = F.vcu; u < NSEQ * 8 * 32; u += F.G) {
        int fr = fr0, g = g0, tid = F.tid; asm volatile("" : "+v"(fr), "+v"(g), "+v"(tid));
        const int n = u & 31, h = (u >> 5) & 7, b = u >> 8; const int tokbase = b * SEQ + n * 128;
        const float ldf = -fabsf(F.prm[PRM_LDF + L * 8 + h]), ldb = -fabsf(F.prm[PRM_LDB + L * 8 + h]);
        {
            v4u q[4], v[8];
#pragma unroll
            for (int i = 0; i < 4; ++i) { const int idx = tid + 512 * i, ch = idx & 15, tok = idx >> 4; q[i] = *(const v4u*)(prt + (size_t)(tokbase + tok) * LD_RT + h * 128 + ch * 8); }
#pragma unroll
            for (int i = 0; i < 8; ++i) { const int idx = tid + 512 * i, ch = idx & 31, tok = idx >> 5; v[i] = *(const v4u*)(prt + (size_t)(tokbase + tok) * LD_RT + 2048 + h * 256 + ch * 8); }
#pragma unroll
            for (int i = 0; i < 4; ++i) { const int idx = tid + 512 * i, ch = idx & 15, tok = idx >> 4; *(LAS v4u*)(F.lds + RO_Q_OFF + tok * RO_QSTRIDE + ch * 16) = q[i]; }
#pragma unroll
            for (int i = 0; i < 8; ++i) { const int idx = tid + 512 * i, ch = idx & 31, tok = idx >> 5; *(LAS v4u*)(F.lds + RO_V_OFF + tok * RO_VSTRIDE + ch * 16) = v[i]; }
        }
        bf16x8 Kf[4];
#pragma unroll
        for (int ks = 0; ks < 4; ++ks) Kf[ks] = *(const bf16x8*)(prt + (size_t)(tokbase + 16 * w + fr) * LD_RT + 1024 + h * 128 + 32 * ks + 8 * g);
        __syncthreads();
#pragma unroll
        for (int tb = 0; tb < 8; ++tb) {
            f32x4 s = (f32x4){0.f, 0.f, 0.f, 0.f};
#pragma unroll
            for (int ks = 0; ks < 4; ++ks) { const bf16x8 Qf = *(const LAS bf16x8*)(F.lds + RO_Q_OFF + (16 * tb + fr) * RO_QSTRIDE + (32 * ks + 8 * g) * 2); s = MFMA16(Kf[ks], Qf, s); }
            const int c = 16 * tb + fr; float p[4];
#pragma unroll
            for (int e = 0; e < 4; ++e) { const int sk = 16 * w + 4 * g + e; const int d = c - sk;
                const float dm = (d > 0) ? expf_(ldf * (float)d) : ((d < 0) ? expf_(ldb * (float)(-d)) : 2.0f);
                p[e] = s[e] * dm; }
            v2u o; o.x = pk2(p[0], p[1]); o.y = pk2(p[2], p[3]);
            *(LAS v2u*)(F.lds + RO_P_OFF + c * RO_QSTRIDE + (16 * w + 4 * g) * 2) = o;
            asm volatile("" ::: "memory");
        }
        f32x4 acc[2][8];
        {
            bf16x8 PF[2][4];
            const bf16* kf = kvs + ((size_t)(((b * 8 + h) * 2 + 0) * 32 + n) * 256) * 128;
#pragma unroll
            for (int blk = 0; blk < 2; ++blk)
#pragma unroll
                for (int ks = 0; ks < 4; ++ks) PF[blk][ks] = *(const bf16x8*)(kf + (size_t)(32 * w + 16 * blk + fr) * 128 + 32 * ks + 8 * g);
#pragma unroll
            for (int tb = 0; tb < 8; ++tb) {
                bf16x8 Qf[4];
#pragma unroll
                for (int ks = 0; ks < 4; ++ks) Qf[ks] = *(const LAS bf16x8*)(F.lds + RO_Q_OFF + (16 * tb + fr) * RO_QSTRIDE + (32 * ks + 8 * g) * 2);
                const int c = 16 * tb + fr; const float ratio = expf_(ldf * (float)(c + 1) - ldb * (float)(128 - c));
#pragma unroll
                for (int blk = 0; blk < 2; ++blk) {
                    f32x4 a = (f32x4){0.f, 0.f, 0.f, 0.f};
#pragma unroll
                    for (int ks = 0; ks < 4; ++ks) a = MFMA16(PF[blk][ks], Qf[ks], a);
                    acc[blk][tb] = a * ratio;
                }
                asm volatile("" ::: "memory");
            }
        }
        {
            bf16x8 PBk[2][4];
            const bf16* kb = kvs + ((size_t)(((b * 8 + h) * 2 + 1) * 32 + n) * 256) * 128;
#pragma unroll
            for (int blk = 0; blk < 2; ++blk)
#pragma unroll
                for (int ks = 0; ks < 4; ++ks) PBk[blk][ks] = *(const bf16x8*)(kb + (size_t)(32 * w + 16 * blk + fr) * 128 + 32 * ks + 8 * g);
#pragma unroll
            for (int tb = 0; tb < 8; ++tb) {
                bf16x8 Qf[4];
#pragma unroll
                for (int ks = 0; ks < 4; ++ks) Qf[ks] = *(const LAS bf16x8*)(F.lds + RO_Q_OFF + (16 * tb + fr) * RO_QSTRIDE + (32 * ks + 8 * g) * 2);
                const int c = 16 * tb + fr; const float eb = expf_(ldb * (float)(128 - c));
#pragma unroll
                for (int blk = 0; blk < 2; ++blk) {
                    f32x4 a = acc[blk][tb];
#pragma unroll
                    for (int ks = 0; ks < 4; ++ks) a = MFMA16(PBk[blk][ks], Qf[ks], a);
                    acc[blk][tb] = a * eb;
                }
                asm volatile("" ::: "memory");
            }
        }
        __syncthreads();
#pragma unroll
        for (int kk = 0; kk < 4; ++kk) {
            const unsigned va = vlds + (32 * kk + 8 * g + (fr >> 2)) * RO_VSTRIDE + (32 * w + 4 * (fr & 3)) * 2;
            bf16x8 V0, V1; tr2x2(V0, V1, va, va + 4 * RO_VSTRIDE, va + 32, va + 32 + 4 * RO_VSTRIDE);
#pragma unroll
            for (int tb = 0; tb < 8; ++tb) {
                const bf16x8 Pf = *(const LAS bf16x8*)(F.lds + RO_P_OFF + (16 * tb + fr) * RO_QSTRIDE + (32 * kk + 8 * g) * 2);
                acc[0][tb] = MFMA16(V0, Pf, acc[0][tb]); acc[1][tb] = MFMA16(V1, Pf, acc[1][tb]);
            }
        }
#pragma unroll
        for (int tb = 0; tb < 8; ++tb) {
            float ss = 0.f;
#pragma unroll
            for (int blk = 0; blk < 2; ++blk) { const f32x4 a = acc[blk][tb]; ss += (a[0] * a[0] + a[1] * a[1]) + (a[2] * a[2] + a[3] * a[3]); }
            ss += __shfl_xor(ss, 16); ss += __shfl_xor(ss, 32);
            if (g == 0) red[w * 128 + 16 * tb + fr] = ss;
        }
        __syncthreads();
        const float* gn = F.prm + PRM_GN + (size_t)L * 2048 + h * 256;
        f32x4 gnv[2];
#pragma unroll
        for (int blk = 0; blk < 2; ++blk) gnv[blk] = *(const f32x4*)(gn + 32 * w + 16 * blk + 4 * g);
#pragma unroll
        for (int tb = 0; tb < 8; ++tb) {
            const int c = 16 * tb + fr; float tot = 0.f;
#pragma unroll
            for (int ww = 0; ww < 8; ++ww) tot += red[ww * 128 + c];
            const float rinv = 1.0f / sqrtf(tot * (1.0f / 256.0f) + EPS);
#pragma unroll
            for (int blk = 0; blk < 2; ++blk) {
                const int dv = 32 * w + 16 * blk + 4 * g;
                const v2u gt = *(const v2u*)(prt + (size_t)(tokbase + c) * LD_RT + 4096 + h * 256 + dv);
                const f32x4 a = acc[blk][tb];
                v2u o; o.x = pk2(a[0] * rinv * gnv[blk][0] * bflo(gt.x), a[1] * rinv * gnv[blk][1] * bfhi(gt.x)); o.y = pk2(a[2] * rinv * gnv[blk][2] * bflo(gt.y), a[3] * rinv * gnv[blk][3] * bfhi(gt.y));
                *(v2u*)(bo + (size_t)(tokbase + c) * 2048 + h * 256 + dv) = o;
            }
        }
        __syncthreads();
    }
}

__device__ __forceinline__ void p6_phase(Frame& F, int L) {
    const bf16* y = (const bf16*)(F.ws + WS_Y); const float* part = (const float*)(F.ws + WS_PART); bf16* xb = (bf16*)(F.ws + WS_XBB); const bf16* xa = (const bf16*)(F.ws + WS_XBA);
    const float* lnp = F.prm + PRM_LNPOST + (size_t)L * DM;
    const int gw = F.vcu * 8 + F.wave, NGW = F.G * 8;
    for (int m = gw; m < NTOK; m += NGW) {
        const float ss = wave_sum(part[(size_t)m * 64 + F.lane]);
        const float rs = 1.0f / sqrtf(ss * (1.0f / DM) + EPS);
        const float* xr = (m < NTOK_P) ? F.xp + (size_t)m * DM : F.xs + (size_t)(m - NTOK_P) * DM;
#pragma unroll 4
        for (int j = 0; j < 16; ++j) { const int col = j * 256 + F.lane * 4;
            f32x4 xv;
            if (L == 0) xv = *(const f32x4*)(xr + col);
            else { const v2u t = *(const v2u*)(xa + (size_t)m * DM + col); xv[0] = bflo(t.x); xv[1] = bfhi(t.x); xv[2] = bflo(t.y); xv[3] = bfhi(t.y); }
            const f32x4 gv = *(const f32x4*)(lnp + col); const v2u yv = *(const v2u*)(y + (size_t)m * DM + col);
            f32x4 o; o[0] = xv[0] + bflo(yv.x) * rs * gv[0]; o[1] = xv[1] + bfhi(yv.x) * rs * gv[1]; o[2] = xv[2] + bflo(yv.y) * rs * gv[2]; o[3] = xv[3] + bfhi(yv.y) * rs * gv[3];
            v2u w; w.x = pk2(o[0], o[1]); w.y = pk2(o[2], o[3]); *(v2u*)(xb + (size_t)m * DM + col) = w; }
    }
}
__device__ __forceinline__ void rstd_phase(Frame& F) {
    const float* part = (const float*)(F.ws + WS_PART2); float* rstd = (float*)(F.ws + WS_RSTD);
    const int gw = F.vcu * 8 + F.wave, NGW = F.G * 8;
    for (int m = gw; m < NTOK; m += NGW) { const float ss = wave_sum(part[(size_t)m * 64 + F.lane]); if (F.lane == 0) rstd[m] = 1.0f / sqrtf(ss * (1.0f / DM) + EPS); }
}

constexpr int NPH = 18;
__global__ void __launch_bounds__(512, 2) fwd(Args args) {
    extern __shared__ __attribute__((aligned(16))) unsigned char lds_raw[];
    Frame F;
    F.lds = (LAS unsigned char*)lds_raw; F.ws = args.ws; F.out = args.out; F.xp = args.in[I_XP]; F.xs = args.in[I_XS]; F.prm = (const float*)(args.ws + WS_PRM);
    F.tid = threadIdx.x; F.lane = F.tid & 63; F.wave = __builtin_amdgcn_readfirstlane(F.tid >> 6);
    F.G = gridDim.x; F.bx = blockIdx.x; { const int bx = blockIdx.x; F.vcu = (F.G % 8 == 0) ? (bx % 8) * (F.G / 8) + bx / 8 : bx; }
    volatile LAS unsigned* MISC = (volatile LAS unsigned*)(F.lds + MISC_OFF);
    if (F.tid < 16) MISC[F.tid] = 0u;
    __syncthreads();
    unsigned* ctl = (unsigned*)(F.ws + WS_CTL);
#if MK_MULTI
    XcdBarrier bar; bar.bar = ctl + CW_BAR; bar.x = 0; bar.st = MISC;
#define GRID_BAR() do { } while (0)
#else
    XcdBarrier bar = xcd_barrier_post(ctl + CW_BAR, MISC);
#define GRID_BAR() xcd_barrier(bar)
#endif
    const int lo = args.ph_lo, hi = args.ph_hi; int rep_mask = args.rep; (void)rep_mask;
#define IN(k) (lo <= (k) && (k) < hi)
#define SEAM(k) do { if (IN(k) && IN((k) + 1)) GRID_BAR(); } while (0)

    if (PH_ON(0) && IN(0)) { REP(0) { LAUNDER(); p0_prologue(F, args); } }
    SEAM(0);
#pragma nounroll
    for (int L = 0; L < DEPTH; ++L) {
        asm volatile("" : "+v"(F.tid), "+s"(F.wave), "+s"(F.vcu), "+s"(F.G), "+s"(F.bx), "+s"(F.ws), "+s"(F.out), "+s"(F.prm));
        F.lane = F.tid & 63;
        const int pb = 1 + 9 * L;
        bf16* xba = (bf16*)(F.ws + WS_XBA); bf16* xbb = (bf16*)(F.ws + WS_XBB);
        if (PH_ON(1) && IN(pb + 0)) {
            pg8::Order<1> S; S.init(NTOK, INW, DM, F.G, F.bx); S.A[0] = (const char*)xba; S.B[0] = (const char*)((bf16*)(F.ws + WS_WIN) + (size_t)L * INW * DM);
            pg8::EpiG1 E{(bf16*)(F.ws + WS_PNA), (bf16*)(F.ws + WS_PRT), (bf16*)(F.ws + WS_PGT), (const float*)(F.ws + WS_RSTD)};
            REP(1) { LAUNDER(); pg8::gemm_phase(F.lds, F.tid, DM, S, E); }
        }
        SEAM(pb + 0);
        if (PH_ON(2) && IN(pb + 1)) { rot_phase(F); }
        SEAM(pb + 1);
        if (IN(pb + 2)) { if (PH_ON(3)) REP(3) { LAUNDER(); na_phase(F, L); } __syncthreads(); if (PH_ON(4)) REP(4) { LAUNDER(); scan_phase(F, L); } }
        SEAM(pb + 2);
        if (PH_ON(5) && IN(pb + 3)) { REP(5) { LAUNDER(); rout_phase(F, L); } }
        SEAM(pb + 3);
        if (PH_ON(6) && IN(pb + 4)) {
            pg8::Order<2> S; S.init(NTOK, DM, 2048, F.G, F.bx);
            S.A[0] = (const char*)(F.ws + WS_AO); S.A[1] = (const char*)(F.ws + WS_BO);
            S.B[0] = (const char*)((bf16*)(F.ws + WS_WPA) + (size_t)L * DM * 2048); S.B[1] = (const char*)((bf16*)(F.ws + WS_WPB) + (size_t)L * DM * 2048);
            pg8::EpiG2 E{(const bf16*)(F.ws + WS_PGT), (bf16*)(F.ws + WS_T), (bf16*)(F.ws + WS_MRG)};
            REP(6) { LAUNDER(); pg8::gemm_phase(F.lds, F.tid, 2048, S, E); }
        }
        SEAM(pb + 4);
        if (PH_ON(7) && IN(pb + 5)) {
#if PH_ON(10)
            { pg8::Order<1> S; S.init(NTOK, DM, DM, F.G, F.bx); S.A[0] = (const char*)(F.ws + WS_MRG); S.B[0] = (const char*)((bf16*)(F.ws + WS_WOUT) + (size_t)L * DM * DM);
              pg8::EpiStore<true> E{(bf16*)(F.ws + WS_Y), (float*)(F.ws + WS_PART)};
              REP(7) { LAUNDER(); pg8::gemm_phase(F.lds, F.tid, DM, S, E); } }
#endif
#if PH_ON(11)
            { pg8::Order<1> S; S.init(NTOK, DM, PLE, F.G, F.bx); S.A[0] = (const char*)((bf16*)(F.ws + WS_PB) + (size_t)L * NTOK * PLE); S.B[0] = (const char*)((bf16*)(F.ws + WS_WPLE) + (size_t)L * DM * PLE);
              pg8::EpiStore<false> E{(bf16*)(F.ws + WS_E), nullptr};
              REP(8) { LAUNDER(); pg8::gemm_phase(F.lds, F.tid, PLE, S, E); } }
#endif
        }
        SEAM(pb + 5);
        if (PH_ON(8) && IN(pb + 6)) { p6_phase(F, L); }
        SEAM(pb + 6);
        if (PH_ON(9) && IN(pb + 7)) {
            pg8::Order<1> S; S.init(NTOK, DM, DM, F.G, F.bx); S.A[0] = (const char*)xbb; S.B[0] = (const char*)((bf16*)(F.ws + WS_WG) + (size_t)L * DM * DM);
            if (L + 1 < DEPTH) { pg8::EpiG4<false> E{xbb, (const bf16*)(F.ws + WS_E), xba, (float*)(F.ws + WS_PART2), F.out}; pg8::gemm_phase(F.lds, F.tid, DM, S, E); }
            else { pg8::EpiG4<true> E{xbb, (const bf16*)(F.ws + WS_E), xba, (float*)(F.ws + WS_PART2), F.out}; pg8::gemm_phase(F.lds, F.tid, DM, S, E); }
        }
        SEAM(pb + 7);
        if (IN(pb + 8) && L + 1 < DEPTH) { rstd_phase(F); }
        if (L + 1 < DEPTH) SEAM(pb + 8);
    }
#undef IN
#undef SEAM
}

extern "C" void kernel_launch(void* const* d_in, const int* in_sizes, int n_in, void* d_out, int out_size, void* d_ws, size_t ws_size, hipStream_t stream) {
    static int grid = 0;
    if (grid == 0) {
        if (n_in != 16 || out_size != NTOK * DM || ws_size < WS_END) { fprintf(stderr, "kernel_launch: unexpected shapes (n_in %d, out %d, ws %zu < %zu); nothing launched\n", n_in, out_size, ws_size, (size_t)WS_END); grid = -1; return; }
        int dev = 0, cus = 0, per_cu = 0;
        if (hipGetDevice(&dev) != hipSuccess || hipDeviceGetAttribute(&cus, hipDeviceAttributeMultiprocessorCount, dev) != hipSuccess) { grid = -1; return; }
        if (hipFuncSetAttribute((const void*)fwd, hipFuncAttributeMaxDynamicSharedMemorySize, LDS_BYTES) != hipSuccess) { fprintf(stderr, "kernel_launch: hipFuncSetAttribute failed\n"); grid = -1; return; }
        if (hipOccupancyMaxActiveBlocksPerMultiprocessor(&per_cu, (const void*)fwd, 512, LDS_BYTES) != hipSuccess || per_cu < 1) fprintf(stderr, "kernel_launch: occupancy query says %d\n", per_cu);
        (void)hipGetLastError();
        grid = cus;
    }
    if (grid < 0) return;
    (void)hipMemsetAsync((char*)d_ws + WS_CTL, 0, CTL_ZERO_BYTES, stream);
    Args a{};
    for (int i = 0; i < 16; ++i) a.in[i] = (const float*)d_in[i];
    a.out = (float*)d_out; a.ws = (unsigned char*)d_ws;
#if MK_MULTI
    for (int p = 0; p < NPH; ++p) { a.ph_lo = p; a.ph_hi = p + 1; hipLaunchKernelGGL(fwd, dim3(grid), dim3(512), LDS_BYTES, stream, a); }
#else
    a.ph_lo = 0; a.ph_hi = NPH; a.rep = REP_MASK; hipLaunchKernelGGL(fwd, dim3(grid), dim3(512), LDS_BYTES, stream, a);
#endif
}
```
